# Optimizing an MI355X kernel written in HIP

```python
import math
import jax, jax.numpy as jnp
from jax import lax
import numpy as np

D_MODEL = 2048
BATCH = 2
SEQ = 16384
DEPTH = 1

CHUNK = 64
D_MIX = D_MODEL
D_SGU = D_MIX // 2
D_ATT = D_MIX - D_SGU
SGU_GROUPS = 8
SGU_GROUP_DIM = D_SGU // SGU_GROUPS
SGU_BLOCK = 128
ATT_HEADS = 8
ATT_VDIM = D_ATT // ATT_HEADS
ATT_QKDIM = ATT_VDIM // 2
N_BUCKETS = 32
MAX_DISTANCE = 128
Q_BLOCK = 128
EPS = 1e-6
SPLITS = (D_SGU, 2 * D_SGU, 3 * D_SGU, 3 * D_SGU + D_ATT, 3 * D_SGU + 2 * D_ATT, 3 * D_SGU + 3 * D_ATT)
D_IN = 3 * D_SGU + 4 * D_ATT

kernel_name = "hymba_sgu_diffattn_block"


def rms_norm(x, g):
    xf = x.astype(jnp.float32)
    y = xf * lax.rsqrt(jnp.mean(xf * xf, axis=-1, keepdims=True) + EPS)
    return (y * g.astype(jnp.float32)).astype(x.dtype)


def layer_norm(x, g, b):
    xf = x.astype(jnp.float32)
    mu = jnp.mean(xf, axis=-1, keepdims=True)
    xc = xf - mu
    y = xc * lax.rsqrt(jnp.mean(xc * xc, axis=-1, keepdims=True) + EPS)
    return (y * g.astype(jnp.float32) + b.astype(jnp.float32)).astype(x.dtype)


def t5_bucket(rel):
    nb = N_BUCKETS // 2
    max_exact = nb // 2
    side = jnp.where(rel > 0, nb, 0)
    n = jnp.abs(rel)
    nf = jnp.maximum(n, 1).astype(jnp.float32)
    large = max_exact + (jnp.log(nf / max_exact) / math.log(MAX_DISTANCE / max_exact)
                         * (nb - max_exact)).astype(jnp.int32)
    large = jnp.minimum(large, nb - 1)
    return side + jnp.where(n < max_exact, n, large)


def spatial_gating(u, v, ln_g, ln_b, w_s, b_s):
    B, S, _ = v.shape
    v = layer_norm(v, ln_g, ln_b)
    nblk = S // SGU_BLOCK
    vb = v.reshape(B, nblk, SGU_BLOCK, SGU_GROUPS, SGU_GROUP_DIM)
    t = jnp.arange(SGU_BLOCK)
    mask = (t[None, :] // CHUNK) <= (t[:, None] // CHUNK)
    w = jnp.where(mask[None], w_s, jnp.zeros((), w_s.dtype))
    mixed = jnp.einsum('gts,bnsgc->bntgc', w, vb) + b_s.T[None, None, :, :, None]
    return u * mixed.reshape(B, S, D_SGU)


def diff_attention(q, k, v, lam, rel_bias):
    B, S = q.shape[0], q.shape[1]
    nblk = S // Q_BLOCK
    scale = ATT_QKDIM ** -0.5
    kpos = jnp.arange(S, dtype=jnp.int32)
    kchunk = kpos // CHUNK
    qs = jnp.moveaxis(q.reshape(B, nblk, Q_BLOCK, ATT_HEADS, 2, ATT_QKDIM), 1, 0)
    neg = jnp.finfo(jnp.float32).min

    def one_block(args):
        i, qb = args
        qpos = i * Q_BLOCK + jnp.arange(Q_BLOCK, dtype=jnp.int32)
        rel = kpos[None, :] - qpos[:, None]
        bias = jnp.moveaxis(rel_bias[t5_bucket(rel)], -1, 0).astype(jnp.float32)
        allowed = kchunk[None, :] <= (qpos // CHUNK)[:, None]
        logits = jnp.einsum('bqhmd,bkhmd->bhmqk', qb, k).astype(jnp.float32) * scale
        logits = jnp.where(allowed, logits + bias[None, :, None], neg)
        p = jax.nn.softmax(logits, axis=-1)
        w = p[:, :, 0] - lam * p[:, :, 1]
        return jnp.einsum('bhqk,bkhd->bqhd', w.astype(v.dtype), v)

    out = lax.map(one_block, (jnp.arange(nblk, dtype=jnp.int32), qs))
    return jnp.moveaxis(out, 0, 1).reshape(B, S, ATT_HEADS, ATT_VDIM)


def setup_inputs(seed: int = 0) -> dict:
    key = jax.random.key(seed)
    ks = jax.random.split(key, 16)
    f = jnp.float32
    x = jax.random.normal(ks[0], (BATCH, SEQ, D_MODEL), f)
    norm_g = 1.0 + 0.02 * jax.random.normal(ks[1], (DEPTH, D_MODEL), f)
    w_in = jax.random.normal(ks[2], (DEPTH, D_MODEL, D_IN), f) * D_MODEL ** -0.5
    sgu_ln_g = 1.0 + 0.02 * jax.random.normal(ks[3], (DEPTH, D_SGU), f)
    sgu_ln_b = 0.02 * jax.random.normal(ks[4], (DEPTH, D_SGU), f)
    sgu_w = jax.random.normal(ks[5], (DEPTH, SGU_GROUPS, SGU_BLOCK, SGU_BLOCK), f) * SGU_BLOCK ** -0.5
    sgu_b = 1.0 + 0.1 * jax.random.normal(ks[6], (DEPTH, SGU_GROUPS, SGU_BLOCK), f)
    lambda_q1 = 0.1 * jax.random.normal(ks[7], (DEPTH, ATT_QKDIM), f)
    lambda_k1 = 0.1 * jax.random.normal(ks[8], (DEPTH, ATT_QKDIM), f)
    lambda_q2 = 0.1 * jax.random.normal(ks[9], (DEPTH, ATT_QKDIM), f)
    lambda_k2 = 0.1 * jax.random.normal(ks[10], (DEPTH, ATT_QKDIM), f)
    subln_g = 1.0 + 0.02 * jax.random.normal(ks[11], (DEPTH, ATT_VDIM), f)
    rel_bias = 0.5 * jax.random.normal(ks[12], (N_BUCKETS, ATT_HEADS), f)
    w_out = jax.random.normal(ks[13], (DEPTH, D_MIX, D_MODEL), f) * D_MIX ** -0.5
    final_g = 1.0 + 0.02 * jax.random.normal(ks[14], (D_MODEL,), f)
    return {"x": x, "norm_g": norm_g, "w_in": w_in, "sgu_ln_g": sgu_ln_g, "sgu_ln_b": sgu_ln_b,
            "sgu_w": sgu_w, "sgu_b": sgu_b, "lambda_q1": lambda_q1, "lambda_k1": lambda_k1,
            "lambda_q2": lambda_q2, "lambda_k2": lambda_k2, "subln_g": subln_g,
            "rel_bias": rel_bias, "w_out": w_out, "final_g": final_g}


def reference(x, norm_g, w_in, sgu_ln_g, sgu_ln_b, sgu_w, sgu_b, lambda_q1, lambda_k1,
              lambda_q2, lambda_k2, subln_g, rel_bias, w_out, final_g):
    B, S, _ = x.shape
    for l in range(DEPTH):
        lambda_init = 0.8 - 0.6 * math.exp(-0.3 * l)
        h = rms_norm(x, norm_g[l])
        z = jnp.einsum('bsd,de->bse', h, w_in[l])
        u, v, g_a, q, k, v_att, g_b = jnp.split(z, SPLITS, axis=-1)
        a_out = spatial_gating(jax.nn.gelu(u), jax.nn.gelu(v), sgu_ln_g[l], sgu_ln_b[l],
                               sgu_w[l], sgu_b[l])
        a_out = a_out * jax.nn.silu(g_a)
        lam = (jnp.exp(jnp.sum(lambda_q1[l].astype(jnp.float32) * lambda_k1[l].astype(jnp.float32)))
               - jnp.exp(jnp.sum(lambda_q2[l].astype(jnp.float32) * lambda_k2[l].astype(jnp.float32)))
               + lambda_init)
        q = q.reshape(B, S, ATT_HEADS, 2, ATT_QKDIM)
        k = k.reshape(B, S, ATT_HEADS, 2, ATT_QKDIM)
        v_att = v_att.reshape(B, S, ATT_HEADS, ATT_VDIM)
        o = diff_attention(q, k, v_att, lam, rel_bias)
        o = rms_norm(o, subln_g[l]) * (1.0 - lambda_init)
        b_out = o.reshape(B, S, D_ATT) * jax.nn.silu(g_b)
        y = jnp.concatenate([a_out, b_out], axis=-1)
        x = x + jnp.einsum('bse,ed->bsd', y, w_out[l])
    return rms_norm(x, final_g)
```

```cpp
#include <hip/hip_runtime.h>
#include <hip/hip_cooperative_groups.h>
#include <cstdio>
#include <cstdint>
namespace cg = cooperative_groups;

#define DI __device__ __forceinline__
typedef unsigned short bf16_t;
using bf16x8 = __attribute__((ext_vector_type(8))) short;
using s16x4  = __attribute__((ext_vector_type(4))) short;
using f32x4  = __attribute__((ext_vector_type(4))) float;
using f32x16 = __attribute__((ext_vector_type(16))) float;
using u32x4  = __attribute__((ext_vector_type(4))) unsigned;
using u32x2  = __attribute__((ext_vector_type(2))) unsigned;
typedef short v4i16_t __attribute__((ext_vector_type(4)));
typedef __attribute__((address_space(3))) const char* lds_cptr;

constexpr int MTOK = 32768, SEQ = 16384, DM = 2048, DIN = 7168;
constexpr float EPS = 1e-6f;
constexpr float LOG2E = 1.4426950408889634f;
constexpr int NTHREADS = 512;
constexpr int LDS_BYTES = 131072;
#ifndef PHASE_MASK
#define PHASE_MASK 31
#endif
#ifndef PROBE_REP
#define PROBE_REP 0
#endif
#ifndef ATT_STAGGER
#define ATT_STAGGER 0
#endif

constexpr size_t SZ_H = (size_t)MTOK * DM * 2;
constexpr size_t SZ_WIN = (size_t)DIN * DM * 2;
constexpr size_t SZ_WOUT = (size_t)DM * DM * 2;
constexpr size_t SZ_SEG = (size_t)MTOK * 1024 * 2;
constexpr size_t WS_H = 0;
constexpr size_t WS_WIN = WS_H + SZ_H;
constexpr size_t WS_WOUT = WS_WIN + SZ_WIN;
constexpr size_t WS_U = WS_WOUT + SZ_WOUT;
constexpr size_t WS_GV = WS_U + SZ_SEG;
constexpr size_t WS_SGA = WS_GV + SZ_SEG;
constexpr size_t WS_SGB = WS_SGA + SZ_SEG;
constexpr size_t WS_Q = WS_SGB + SZ_SEG;
constexpr size_t WS_K = WS_Q + SZ_SEG;
constexpr size_t WS_V = WS_K + SZ_SEG;
constexpr size_t WS_Y = WS_V + SZ_SEG;
constexpr size_t WS_END = WS_Y + SZ_H;

struct Params {
    const float* in[15];
    float* out;
    char* ws;
};

typedef __bf16 bf16x2_t __attribute__((ext_vector_type(2)));
typedef float f32x2_t __attribute__((ext_vector_type(2)));
DI unsigned pk2(float lo, float hi) { f32x2_t v = {lo, hi}; bf16x2_t b = __builtin_convertvector(v, bf16x2_t); return __builtin_bit_cast(unsigned, b); }
DI float bflo(unsigned u) { return __uint_as_float(u << 16); }
DI float bfhi(unsigned u) { return __uint_as_float(u & 0xffff0000u); }
DI float wave_sum(float v) {
#pragma unroll
    for (int o = 1; o < 64; o <<= 1) v += __shfl_xor(v, o);
    return v;
}
DI float ex2(float x) { return __builtin_amdgcn_exp2f(x); }
DI int fresh_tid(int wid) { int z = 0; asm volatile("" : "+v"(z)); return wid * 64 + (int)__builtin_amdgcn_mbcnt_hi(~0u, __builtin_amdgcn_mbcnt_lo(~0u, (unsigned)z)); }
DI float gelu_f(float x) {
    const float c1 = 2.0f * 0.7978845608028654f * LOG2E, c2 = c1 * 0.044715f;
    const float z = x * (c1 + c2 * x * x);
    return x * __builtin_amdgcn_rcpf(1.0f + ex2(-z));
}
DI float silu_f(float x) { return x * __builtin_amdgcn_rcpf(1.0f + ex2(-x * LOG2E)); }
DI float swap_max(float m) { auto rr = __builtin_amdgcn_permlane32_swap(__float_as_uint(m), __float_as_uint(m), false, false); return __builtin_fmaxf(__uint_as_float(rr[0]), __uint_as_float(rr[1])); }
DI float swap_sum(float m) { auto rr = __builtin_amdgcn_permlane32_swap(__float_as_uint(m), __float_as_uint(m), false, false); return __uint_as_float(rr[0]) + __uint_as_float(rr[1]); }
DI s16x4 vtr(lds_cptr p) { return __builtin_bit_cast(s16x4, __builtin_amdgcn_ds_read_tr16_b64_v4i16((__attribute__((address_space(3))) v4i16_t*)p)); }
#define MFMA32(a, b, c) __builtin_amdgcn_mfma_f32_32x32x16_bf16((a), (b), (c), 0, 0, 0)
#define MFMA16(a, b, c) __builtin_amdgcn_mfma_f32_16x16x32_bf16((a), (b), (c), 0, 0, 0)

DI void p0_rmsnorm_rows(const float* x, const float* g, bf16_t* h, int gw, int nw, int lane) {
    for (int row = gw; row < MTOK; row += nw) {
        const f32x4* xr = (const f32x4*)(x + (size_t)row * DM) + lane;
        f32x4 v[8]; float s = 0.f;
#pragma unroll
        for (int j = 0; j < 8; ++j) { v[j] = xr[64 * j]; s += (v[j].x * v[j].x + v[j].y * v[j].y) + (v[j].z * v[j].z + v[j].w * v[j].w); }
        s = wave_sum(s);
        const float rstd = __builtin_amdgcn_rsqf(s * (1.0f / DM) + EPS);
        u32x2* o8 = (u32x2*)(h + (size_t)row * DM) + lane;
#pragma unroll
        for (int j = 0; j < 8; ++j) {
            const f32x4 gg = ((const f32x4*)g)[lane + 64 * j];
            u32x2 o; o.x = pk2(v[j].x * rstd * gg.x, v[j].y * rstd * gg.y); o.y = pk2(v[j].z * rstd * gg.z, v[j].w * rstd * gg.w);
            o8[64 * j] = o;
        }
    }
}
DI void p0_transpose_item(const float* W, int K, int N, bf16_t* WT, float* scr, int item, int lane) {
    const int nblk = N / 32, kb = item / nblk, nb = item % nblk, k0 = 64 * kb, n0 = 32 * nb;
#pragma unroll 8
    for (int i = 0; i < 32; ++i) { const int kk = 2 * i + (lane >> 5); scr[kk * 33 + (lane & 31)] = W[(size_t)(k0 + kk) * N + n0 + (lane & 31)]; }
    asm volatile("s_waitcnt vmcnt(0) lgkmcnt(0)" ::: "memory");
    const int c = lane & 7;
#pragma unroll
    for (int j = 0; j < 4; ++j) {
        const int n = (lane >> 3) + 8 * j; const float* s = scr + (8 * c) * 33 + n;
        u32x4 o; o.x = pk2(s[0], s[33]); o.y = pk2(s[66], s[99]); o.z = pk2(s[132], s[165]); o.w = pk2(s[198], s[231]);
        *(u32x4*)(WT + (size_t)(n0 + n) * K + k0 + 8 * c) = o;
    }
    asm volatile("s_waitcnt lgkmcnt(0)" ::: "memory");
}

constexpr int BM = 256, BK = 64, HALF = 128, HT = HALF * BK;
DI int lds_byte(int r, int c) { int st = (r >> 4) * 2 + (c >> 5), rr = r & 15, cc = c & 31, ob = rr * 64 + cc * 2; return st * 1024 + (ob ^ (((ob >> 9) & 1) << 5)); }
DI void stage_rc(int b, int& R, int& C) { int st = b / 1024, sb = b % 1024, swz = sb ^ (((sb >> 9) & 1) << 5); R = (st >> 1) * 16 + swz / 64; C = (st & 1) * 32 + (swz % 64) / 2; }

DI void tile_order(int L, int nM, int nN, int& pm, int& pn) {
    const int nwg = nM * nN; int wgid = L;
    { const int q = nwg / 8, r = nwg % 8, xcd = wgid % 8, off = wgid / 8; wgid = (xcd < r ? xcd * (q + 1) : r * (q + 1) + (xcd - r) * q) + off; }
    const int nig = 8 * nN, gid = wgid / nig, fm = gid * 8, gsz = (nM - fm) < 8 ? (nM - fm) : 8;
    pm = fm + ((wgid % nig) % gsz); pn = (wgid % nig) / gsz;
}

typedef __attribute__((address_space(3))) unsigned char* lds_ptr;
template <int EPI>
DI void gemm_epilogue(const f32x4 (&acc)[2][2][4][2], const int brow, const int bcol, const int wr, const int wc, const int fr, const int fq, const Params& p) {
    if (EPI == 0) {
        const int seg = bcol >> 10;
        bf16_t* segbase = (bf16_t*)(p.ws + (seg == 0 ? WS_U : seg == 1 ? WS_GV : seg == 2 ? WS_SGA : seg == 3 ? WS_Q : seg == 4 ? WS_K : seg == 5 ? WS_V : WS_SGB));
        const int c8 = (fq & 1) ? 16 + 4 * (fq - 1) : 4 * fq;
#pragma unroll
        for (int ai = 0; ai < 2; ++ai)
#pragma unroll
        for (int m = 0; m < 4; ++m) {
            const int row = brow + ai * HALF + wr * 64 + m * 16 + fr;
            const int bb = row >> 14, s = row & (SEQ - 1);
#pragma unroll
            for (int bj = 0; bj < 2; ++bj) {
                u32x2 og[2];
#pragma unroll
                for (int n = 0; n < 2; ++n) {
                    f32x4 v = acc[ai][bj][m][n];
                    if (seg == 1) { v.x = gelu_f(v.x); v.y = gelu_f(v.y); v.z = gelu_f(v.z); v.w = gelu_f(v.w); }
                    else if (seg == 3) { const float sc = 0.125f * LOG2E; v.x *= sc; v.y *= sc; v.z *= sc; v.w *= sc; }
                    og[n].x = pk2(v.x, v.y); og[n].y = pk2(v.z, v.w);
                }
                const auto rx = __builtin_amdgcn_permlane16_swap(og[0].x, og[1].x, false, false);
                const auto ry = __builtin_amdgcn_permlane16_swap(og[0].y, og[1].y, false, false);
                u32x4 o; o.x = rx[0]; o.y = ry[0]; o.z = rx[1]; o.w = ry[1];
                const int col = (bcol & 1023) + bj * HALF + wc * 32 + c8;
                size_t idx;
                if (seg <= 2 || seg == 6) idx = (size_t)row * 1024 + col;
                else if (seg == 3) { const int hh = col >> 7, mp = (col >> 6) & 1, d = col & 63;
                    idx = ((((size_t)((bb * 8 + hh) * 2 + mp) * (SEQ / 32) + (s >> 5)) * 4 + (d >> 4)) * 64 + (s & 31) + 32 * ((d >> 3) & 1)) * 8; }
                else if (seg == 4) { const int hh = col >> 7, mp = (col >> 6) & 1, d = col & 63;
                    idx = ((((size_t)(bb * 8 + hh) * 256 + (s >> 6)) * 2 + mp) * 8 + (d >> 3)) * 512 + (size_t)(s & 63) * 8; }
                else { const int hh = col >> 7, dv = col & 127;
                    idx = (((size_t)(bb * 8 + hh) * 256 + (s >> 6)) * 4 + (dv >> 5)) * 2048 + (size_t)(s & 63) * 32 + (dv & 31); }
                *(u32x4*)(segbase + idx) = o;
            }
            __builtin_amdgcn_sched_barrier(0);
        }
    } else {
        bf16_t* dl = (bf16_t*)(p.ws + WS_H);
        const int c8 = (fq & 1) ? 16 + 4 * (fq - 1) : 4 * fq;
#pragma unroll
        for (int ai = 0; ai < 2; ++ai)
#pragma unroll
        for (int m = 0; m < 4; ++m) {
            const int row = brow + ai * HALF + wr * 64 + m * 16 + fr;
#pragma unroll
            for (int bj = 0; bj < 2; ++bj) {
                u32x2 og[2];
#pragma unroll
                for (int n = 0; n < 2; ++n) { const f32x4 v = acc[ai][bj][m][n]; og[n].x = pk2(v.x, v.y); og[n].y = pk2(v.z, v.w); }
                const auto rx = __builtin_amdgcn_permlane16_swap(og[0].x, og[1].x, false, false);
                const auto ry = __builtin_amdgcn_permlane16_swap(og[0].y, og[1].y, false, false);
                u32x4 o; o.x = rx[0]; o.y = ry[0]; o.z = rx[1]; o.w = ry[1];
                const int col = bcol + bj * HALF + wc * 32 + c8;
                *(u32x4*)(dl + (size_t)row * DM + col) = o;
            }
        }
    }
}

template <int EPI>
DI void gemm_phase(lds_ptr lds, const bf16_t* __restrict__ Ag, const bf16_t* __restrict__ Btg, const int K, const int nM, const int nN, const int bid, const int G, const Params& p, const int wid0) {
    int tid_l = fresh_tid(wid0);
    const int tid = tid_l, wid = __builtin_amdgcn_readfirstlane(tid >> 6), lane = tid & 63, wr = wid >> 2, wc = wid & 3, fr = lane & 15, fq = lane >> 4;
    const int nt = K / BK, nunits = nM * nN;
    constexpr int HTB = HALF * BK * 2;
    unsigned voff[2];
#pragma unroll
    for (int i = 0; i < 2; ++i) { int R, C; stage_rc(tid * 16 + i * 8192, R, C); voff[i] = (unsigned)(R * K + C) * 2u; }
    const size_t kstep = (size_t)(BK * 2), hstep = (size_t)HALF * K * 2, tstep = 2 * hstep;
    const unsigned ldsw = (unsigned)wid * 1024u;
    const int aoff = lds_byte(wr * 64 + fr, fq * 8), boff = lds_byte(wc * 32 + fr, fq * 8);
#define SAo(b, h) (((b) * 2 + (h)) * HTB)
#define SBo(b, h) ((4 + (b) * 2 + (h)) * HTB)
#define STAGE(bufoff, gbase) do { _Pragma("unroll") for (int _i = 0; _i < 2; ++_i) \
        __builtin_amdgcn_global_load_lds((const __attribute__((address_space(1))) unsigned*)((const char*)(gbase) + voff[_i]), (__attribute__((address_space(3))) unsigned*)(lds + (bufoff) + ldsw + _i * 8192), 16, 0, 0); } while (0)
#define LDA(dst, b, h) do { _Pragma("unroll") for (int m = 0; m < 4; ++m) _Pragma("unroll") for (int k = 0; k < 2; ++k) dst[m][k] = *(const __attribute__((address_space(3))) bf16x8*)(lds + SAo(b, h) + aoff + m * 2048 + k * 1024); } while (0)
#define LDB(dst, b, h) do { _Pragma("unroll") for (int n = 0; n < 2; ++n) _Pragma("unroll") for (int k = 0; k < 2; ++k) dst[n][k] = *(const __attribute__((address_space(3))) bf16x8*)(lds + SBo(b, h) + boff + n * 2048 + k * 1024); } while (0)
#define MMA(ai, bj, At_, Bt_) do { __builtin_amdgcn_s_setprio(1); _Pragma("unroll") for (int m = 0; m < 4; ++m) _Pragma("unroll") for (int n = 0; n < 2; ++n) _Pragma("unroll") for (int k = 0; k < 2; ++k) \
        acc[ai][bj][m][n] = MFMA16(Bt_[n][k], At_[m][k], acc[ai][bj][m][n]); __builtin_amdgcn_s_setprio(0); } while (0)
#define WAIT_V(n) asm volatile("s_waitcnt vmcnt(" #n ")" ::: "memory")
#define WAIT_L(n) asm volatile("s_waitcnt lgkmcnt(" #n ")" ::: "memory")
#define BAR __builtin_amdgcn_s_barrier()
#define SCHED __builtin_amdgcn_sched_barrier(0)
    if (bid >= nunits) return;
    int ui = 0, cpm, cpn, npm = 0, npn = 0;
    tile_order(bid, nM, nN, cpm, cpn);
    f32x4 acc[2][2][4][2];
#pragma unroll
    for (int a = 0; a < 2; ++a)
#pragma unroll
        for (int b = 0; b < 2; ++b)
#pragma unroll
            for (int m = 0; m < 4; ++m)
#pragma unroll
                for (int n = 0; n < 2; ++n) acc[a][b][m][n] = (f32x4){0.f, 0.f, 0.f, 0.f};
    bf16x8 At[4][2], B0[2][2], B1[2][2];
    const char* cA = (const char*)Ag + (size_t)cpm * tstep; const char* cB = (const char*)Btg + (size_t)cpn * tstep;
    STAGE(SBo(0, 0), cB); STAGE(SAo(0, 0), cA); STAGE(SBo(0, 1), cB + hstep); STAGE(SAo(0, 1), cA + hstep);
    if (wr == 1) BAR;
    WAIT_V(4); BAR;
    STAGE(SBo(1, 0), cB + kstep); STAGE(SAo(1, 0), cA + kstep); STAGE(SBo(1, 1), cB + hstep + kstep);
    WAIT_V(6); BAR;
    for (;;) {
        const bool has_next = (ui + 1) * G + bid < nunits;
        if (has_next) tile_order((ui + 1) * G + bid, nM, nN, npm, npn);
        const char* nA = has_next ? (const char*)Ag + (size_t)npm * tstep : cA; const char* nB = has_next ? (const char*)Btg + (size_t)npn * tstep : cB;
        for (int t = 0; t < nt; t += 2) {
            const bool last = (t == nt - 2);
            const char* a1 = cA + (size_t)(t + 1) * kstep;
            const char* a2 = last ? nA : cA + (size_t)(t + 2) * kstep; const char* b2 = last ? nB : cB + (size_t)(t + 2) * kstep;
            const char* a3 = a2 + kstep; const char* b3 = b2 + kstep;
            LDB(B0, 0, 0); SCHED; LDA(At, 0, 0); STAGE(SAo(1, 1), a1 + hstep);
            WAIT_L(8); BAR; WAIT_L(0); MMA(0, 0, At, B0); BAR; SCHED;
            LDB(B1, 0, 1); STAGE(SBo(0, 0), b2);
            BAR; WAIT_L(0); MMA(0, 1, At, B1); BAR;
            LDA(At, 0, 1); STAGE(SAo(0, 0), a2);
            BAR; WAIT_L(0); MMA(1, 0, At, B0); BAR; SCHED;
            STAGE(SBo(0, 1), b2 + hstep);
            WAIT_V(6); BAR; MMA(1, 1, At, B1); BAR;
            LDB(B0, 1, 0); SCHED; LDA(At, 1, 0); STAGE(SAo(0, 1), a2 + hstep);
            WAIT_L(8); BAR; WAIT_L(0); MMA(0, 0, At, B0); BAR; SCHED;
            LDB(B1, 1, 1); STAGE(SBo(1, 0), b3);
            BAR; WAIT_L(0); MMA(0, 1, At, B1); BAR;
            LDA(At, 1, 1); STAGE(SAo(1, 0), a3);
            BAR; WAIT_L(0); MMA(1, 0, At, B0); BAR; SCHED;
            STAGE(SBo(1, 1), b3 + hstep);
            WAIT_V(6); BAR; MMA(1, 1, At, B1); BAR;
        }
        gemm_epilogue<EPI>(acc, cpm * BM, cpn * BM, wr, wc, fr, fq, p);
        if (!has_next) break;
#pragma unroll
        for (int a = 0; a < 2; ++a)
#pragma unroll
            for (int b = 0; b < 2; ++b)
#pragma unroll
                for (int m = 0; m < 4; ++m)
#pragma unroll
                    for (int n = 0; n < 2; ++n) acc[a][b][m][n] = (f32x4){0.f, 0.f, 0.f, 0.f};
        cpm = npm; cpn = npn; cA = nA; cB = nB; ++ui;
    }
    WAIT_V(0);
    if (wr == 0) BAR;
    BAR;
#undef SAo
#undef SBo
#undef STAGE
#undef LDA
#undef LDB
#undef MMA
}

DI void sgu_item(const Params& p, int item, char* lds, int tid, int lane, int wid) {
    const int r0 = item * 128, r32 = lane & 31, hi = lane >> 5;
    const bf16_t* GV = (const bf16_t*)(p.ws + WS_GV); const bf16_t* U = (const bf16_t*)(p.ws + WS_U); const bf16_t* SGA = (const bf16_t*)(p.ws + WS_SGA);
    bf16_t* Y = (bf16_t*)(p.ws + WS_Y);
    float* stats = (float*)(lds + 98304);
#pragma unroll 1
    for (int rb = 0; rb < 16; rb += 8) {
        u32x4 a[8], b2[8];
#pragma unroll
        for (int rr = 0; rr < 8; ++rr) { const u32x4* src = (const u32x4*)(GV + (size_t)(r0 + 16 * wid + rb + rr) * 1024); a[rr] = src[lane]; b2[rr] = src[lane + 64]; }
#pragma unroll
        for (int rr = 0; rr < 8; ++rr) {
            float s = 0.f, ss = 0.f;
#pragma unroll
            for (int e = 0; e < 4; ++e) { float f0 = bflo(a[rr][e]), f1 = bfhi(a[rr][e]), f2 = bflo(b2[rr][e]), f3 = bfhi(b2[rr][e]); s += (f0 + f1) + (f2 + f3); ss += (f0 * f0 + f1 * f1) + (f2 * f2 + f3 * f3); }
            s = wave_sum(s); ss = wave_sum(ss);
            if (lane == 0) { const float mean = s * (1.f / 1024.f); const float var = ss * (1.f / 1024.f) - mean * mean; stats[(16 * wid + rb + rr) * 2] = mean; stats[(16 * wid + rb + rr) * 2 + 1] = __builtin_amdgcn_rsqf(var + EPS); }
        }
    }
    __syncthreads();
    const float* lng = p.in[3]; const float* lnb = p.in[4]; const float* sw = p.in[5]; const float* sb = p.in[6];
    const int tb = wid & 3, ch = wid >> 2, t = tb * 32 + r32;
    for (int g = 0; g < 8; ++g) {
#pragma unroll
        for (int i = 0; i < 4; ++i) {
            const int q = tid + 512 * i, s = q >> 4, cc = q & 15;
            const u32x4 raw = *(const u32x4*)(GV + (size_t)(r0 + s) * 1024 + g * 128 + cc * 8);
            const float mean = stats[2 * s], rstd = stats[2 * s + 1];
            const f32x4 g0 = *(const f32x4*)(lng + g * 128 + cc * 8), g1 = *(const f32x4*)(lng + g * 128 + cc * 8 + 4);
            const f32x4 b0 = *(const f32x4*)(lnb + g * 128 + cc * 8), b1 = *(const f32x4*)(lnb + g * 128 + cc * 8 + 4);
            u32x4 o;
            o.x = pk2((bflo(raw.x) - mean) * rstd * g0.x + b0.x, (bfhi(raw.x) - mean) * rstd * g0.y + b0.y);
            o.y = pk2((bflo(raw.y) - mean) * rstd * g0.z + b0.z, (bfhi(raw.y) - mean) * rstd * g0.w + b0.w);
            o.z = pk2((bflo(raw.z) - mean) * rstd * g1.x + b1.x, (bfhi(raw.z) - mean) * rstd * g1.y + b1.y);
            o.w = pk2((bflo(raw.w) - mean) * rstd * g1.z + b1.z, (bfhi(raw.w) - mean) * rstd * g1.w + b1.w);
            *(u32x4*)(lds + (cc >> 2) * 8192 + s * 64 + (cc & 3) * 16) = o;
        }
        __syncthreads();
        f32x16 d[2]; d[0] = f32x16{}; d[1] = f32x16{};
        const float* wrow = sw + ((size_t)g * 128 + t) * 128;
        const lds_cptr vp = (lds_cptr)lds + ((lane >> 4) & 1) * 32 + (lane & 3) * 8 + ((lane & 15) >> 2) * 64;
#pragma unroll
        for (int ks = 0; ks < 8; ++ks) {
            const int s0 = 16 * ks + 8 * hi;
            f32x4 w0 = *(const f32x4*)(wrow + s0), w1 = *(const f32x4*)(wrow + s0 + 4);
            if ((s0 >> 6) > (t >> 6)) { w0 = f32x4{0.f, 0.f, 0.f, 0.f}; w1 = w0; }
            u32x4 wp; wp.x = pk2(w0.x, w0.y); wp.y = pk2(w0.z, w0.w); wp.z = pk2(w1.x, w1.y); wp.w = pk2(w1.z, w1.w);
            const bf16x8 wf = __builtin_bit_cast(bf16x8, wp);
#pragma unroll
            for (int cbi = 0; cbi < 2; ++cbi) {
                const int cb = 2 * ch + cbi;
                const s16x4 lo = vtr(vp + cb * 8192 + s0 * 64), hi4 = vtr(vp + cb * 8192 + (s0 + 4) * 64);
                const bf16x8 vf = __builtin_shufflevector(lo, hi4, 0, 1, 2, 3, 4, 5, 6, 7);
                d[cbi] = MFMA32(vf, wf, d[cbi]);
            }
            if (ks & 1) __builtin_amdgcn_sched_barrier(0);
        }
        const float bs = sb[g * 128 + t];
        char* stg = lds + 32768;
#pragma unroll
        for (int cbi = 0; cbi < 2; ++cbi)
#pragma unroll
        for (int ig = 0; ig < 4; ++ig) {
            const int cl = (2 * ch + cbi) * 32 + 8 * ig + 4 * hi;
            u32x2 o; o.x = pk2(d[cbi][4 * ig] + bs, d[cbi][4 * ig + 1] + bs); o.y = pk2(d[cbi][4 * ig + 2] + bs, d[cbi][4 * ig + 3] + bs);
            *(u32x2*)(stg + t * 272 + cl * 2) = o;
        }
        __syncthreads();
#pragma unroll
        for (int i = 0; i < 4; ++i) {
            const int q = tid + 512 * i, r = q >> 4, cc = q & 15;
            const u32x4 mx = *(const u32x4*)(stg + r * 272 + cc * 16);
            const size_t rw = (size_t)(r0 + r); const int c = g * 128 + cc * 8;
            const u32x4 uu = *(const u32x4*)(U + rw * 1024 + c), gg = *(const u32x4*)(SGA + rw * 1024 + c);
            u32x4 o;
            o.x = pk2(gelu_f(bflo(uu.x)) * bflo(mx.x) * silu_f(bflo(gg.x)), gelu_f(bfhi(uu.x)) * bfhi(mx.x) * silu_f(bfhi(gg.x)));
            o.y = pk2(gelu_f(bflo(uu.y)) * bflo(mx.y) * silu_f(bflo(gg.y)), gelu_f(bfhi(uu.y)) * bfhi(mx.y) * silu_f(bfhi(gg.y)));
            o.z = pk2(gelu_f(bflo(uu.z)) * bflo(mx.z) * silu_f(bflo(gg.z)), gelu_f(bfhi(uu.z)) * bfhi(mx.z) * silu_f(bfhi(gg.z)));
            o.w = pk2(gelu_f(bflo(uu.w)) * bflo(mx.w) * silu_f(bflo(gg.w)), gelu_f(bfhi(uu.w)) * bfhi(mx.w) * silu_f(bfhi(gg.w)));
            *(u32x4*)(Y + rw * 2048 + c) = o;
        }
    }
    __syncthreads();
}

DI int t5_bucket_dev(int rel) {
    const int side = rel > 0 ? 16 : 0; const int n = rel < 0 ? -rel : rel;
    int v;
    if (n < 8) v = n; else if (n < 12) v = 8; else if (n < 16) v = 9; else if (n < 23) v = 10; else if (n < 32) v = 11; else if (n < 46) v = 12; else if (n < 64) v = 13; else if (n < 91) v = 14; else v = 15;
    return side + v;
}

DI void attn_unit(const Params& p, int bh, int qb, char* lds, float lam, int tid, int lane, int wid, const bool build_tab) {
    const int h = bh & 7, b = bh >> 3;
    const int map = wid & 1, qblk = wid >> 1, r32 = lane & 31, hi = lane >> 5;
    const int NT = 2 * qb + 2, ntw = 2 * qb + 1 + (qblk >> 1);
    float* tab = (float*)(lds + 98304);
    const char* KGc = p.ws + WS_K + ((size_t)bh * 256 << 14) + tid * 16;
    const char* VGc = p.ws + WS_V + ((size_t)bh * 256 << 14) + tid * 16;
#define GLDS16(gp_, ldsoff_) do { unsigned sv_; asm volatile("s_mov_b32 %0, m0\n\ts_mov_b32 m0, %2\n\ts_nop 0\n\tglobal_load_lds_dwordx4 %1, off\n\ts_mov_b32 m0, %0" : "=&s"(sv_) : "v"(gp_), "s"(ldsoff_) : "memory"); } while (0)
#define GLOAD(t_, slotoff_) do { const char* kb_ = KGc + ((size_t)(t_) << 14); const char* vb_ = VGc + ((size_t)(t_) << 14); \
        const unsigned d_ = (unsigned)__builtin_amdgcn_readfirstlane((int)(ldsbase + (slotoff_) + wid * 1024)); \
        GLDS16(kb_, d_); GLDS16(kb_ + 8192, d_ + 8192u); GLDS16(vb_, d_ + 16384u); GLDS16(vb_ + 8192, d_ + 24576u); } while (0)
    const unsigned ldsbase = (unsigned)(uintptr_t)(__attribute__((address_space(3))) char*)lds;
#define SCHEDB() __builtin_amdgcn_sched_barrier(0)
    const int qrow0 = 128 * qb + 32 * qblk;
    bf16x8 qf[4];
    { const bf16_t* qblkp = (const bf16_t*)(p.ws + WS_Q) + (((size_t)(bh * 2 + map) * (SEQ / 32) + (qrow0 >> 5)) * 4 * 64 + lane) * 8;
#pragma unroll
      for (int d0 = 0; d0 < 4; ++d0) qf[d0] = *(const bf16x8*)(qblkp + d0 * 64 * 8); }
    GLOAD(0, 0);
    GLOAD(1, 32768);
    if (build_tab && tid < 320) { const float* rb = p.in[12]; const int rel = tid - 256; tab[tid] = rel < -128 ? 0.f : (rb[t5_bucket_dev(rel) * 8 + h] - rb[15 * 8 + h]) * LOG2E; }
    asm volatile("s_waitcnt vmcnt(0)" ::: "memory");
    __syncthreads();
    const bool grpB = wid >= 4;
    if (ATT_STAGGER && grpB) __builtin_amdgcn_s_barrier();
    f32x16 o[4]; o[0] = f32x16{}; o[1] = f32x16{}; o[2] = f32x16{}; o[3] = f32x16{};
    float l = 0.f, nm = 0.f;
    f32x16 cinit = f32x16{};
    int sc = 0, sn1 = 32768, sn2 = 65536;
#define LOADV(dst, ks_) do { _Pragma("unroll") for (int dvb = 0; dvb < 4; ++dvb) { dst[2 * dvb] = vtr(vp + dvb * 4096 + (ks_) * 1024); dst[2 * dvb + 1] = vtr(vp + dvb * 4096 + (ks_) * 1024 + 512); } } while (0)
#define MF4(src, pfrag) do { _Pragma("unroll") for (int dvb = 0; dvb < 4; ++dvb) { \
        const bf16x8 vf_ = __builtin_shufflevector(src[2 * dvb], src[2 * dvb + 1], 0, 1, 2, 3, 4, 5, 6, 7); o[dvb] = MFMA32(vf_, pfrag, o[dvb]); } } while (0)
#define MX3(a_, b_, c_) __builtin_fmaxf(__builtin_fmaxf((a_), (b_)), (c_))
    for (int t = 0; t < NT; ++t) {
        const bool act = t < ntw;
        const lds_cptr vp = (lds_cptr)lds + sc + 16384 + ((lane >> 4) & 1) * 32 + (lane & 3) * 8 + (4 * hi + ((lane & 15) >> 2)) * 64;
        bf16x8 pf[4]; s16x4 va[8], vb[8];
        if (act) {
            const lds_cptr kp = (lds_cptr)lds + sc + map * 8192 + hi * 1024 + r32 * 16;
            bf16x8 kf[8];
#pragma unroll
            for (int d0 = 0; d0 < 4; ++d0) {
                kf[2 * d0] = *(const __attribute__((address_space(3))) bf16x8*)(kp + d0 * 2048);
                kf[2 * d0 + 1] = *(const __attribute__((address_space(3))) bf16x8*)(kp + d0 * 2048 + 512);
            }
            f32x16 s0 = cinit, s1 = cinit;
#pragma unroll
            for (int d0 = 0; d0 < 4; ++d0) { s0 = MFMA32(kf[2 * d0], qf[d0], s0); s1 = MFMA32(kf[2 * d0 + 1], qf[d0], s1); }
            LOADV(va, 0);
            if (t >= 2 * qb - 2) {
                const float* tb = tab + (64 * t - (qrow0 + r32) + 256 + 4 * hi);
#pragma unroll
                for (int i = 0; i < 16; ++i) {
                    s0[i] += tb[(i & 3) + 8 * (i >> 2)];
                    s1[i] += tb[(i & 3) + 8 * (i >> 2) + 32];
                }
            }
            float mxa = MX3(s0[0], s0[1], s1[0]), mxb = MX3(s0[2], s0[3], s1[1]); mxa = MX3(mxa, s1[2], s1[3]);
#pragma unroll
            for (int r = 4; r < 16; r += 4) { mxa = MX3(mxa, s0[r], s0[r + 1]); mxb = MX3(mxb, s0[r + 2], s0[r + 3]); mxa = MX3(mxa, s1[r], s1[r + 1]); mxb = MX3(mxb, s1[r + 2], s1[r + 3]); }
            float mx = swap_max(__builtin_fmaxf(mxa, mxb));
            const bool first = (t == 0);
            if (first || __builtin_amdgcn_ballot_w64(mx > 8.0f) != 0ull) {
                const float dl = first ? mx : __builtin_fmaxf(mx, 0.f);
                const float f = first ? 1.0f : ex2(-dl);
                l *= f; nm -= dl;
#pragma unroll
                for (int i = 0; i < 16; ++i) { o[0][i] *= f; o[1][i] *= f; o[2][i] *= f; o[3][i] *= f; cinit[i] = nm; s0[i] -= dl; s1[i] -= dl; }
            }
            asm volatile("s_waitcnt vmcnt(0)" ::: "memory");
            if (t + 2 < NT) GLOAD(t + 2, sn2);
            float rs0 = 0.f, rs1 = 0.f;
#define EXPQ(S, lo_, RS, PF) do { _Pragma("unroll") for (int i = lo_; i < lo_ + 8; ++i) { S[i] = ex2(S[i]); RS += S[i]; } \
              u32x4 w_; w_.x = pk2(S[lo_], S[lo_ + 1]); w_.y = pk2(S[lo_ + 2], S[lo_ + 3]); w_.z = pk2(S[lo_ + 4], S[lo_ + 5]); w_.w = pk2(S[lo_ + 6], S[lo_ + 7]); PF = __builtin_bit_cast(bf16x8, w_); } while (0)
            EXPQ(s0, 0, rs0, pf[0]);
            LOADV(vb, 1);
            MF4(va, pf[0]);
            EXPQ(s0, 8, rs1, pf[1]);
            LOADV(va, 2);
            MF4(vb, pf[1]);
            EXPQ(s1, 0, rs0, pf[2]);
            LOADV(vb, 3);
            MF4(va, pf[2]);
            EXPQ(s1, 8, rs1, pf[3]);
            MF4(vb, pf[3]);
            l += rs0 + rs1;
#undef EXPQ
        } else {
            asm volatile("s_waitcnt vmcnt(0)" ::: "memory");
            if (t + 2 < NT) GLOAD(t + 2, sn2);
        }
        SCHEDB();
        __builtin_amdgcn_s_barrier();
        SCHEDB();
        { const int tmp = sc; sc = sn1; sn1 = sn2; sn2 = tmp; }
    }
#undef LOADV
#undef MF4
#undef MX3
    if (ATT_STAGGER && !grpB) __builtin_amdgcn_s_barrier();
    asm volatile("s_waitcnt vmcnt(0) lgkmcnt(0)" ::: "memory");
    __syncthreads();
#undef GLOAD
#undef SCHEDB
    const float lt = swap_sum(l);
    const float inv = __builtin_amdgcn_rcpf(lt);
    float* xch = (float*)lds + qblk * 4096;
    if (map == 1) {
        const float sc = inv * lam;
#pragma unroll
        for (int dvb = 0; dvb < 4; ++dvb)
#pragma unroll
        for (int i = 0; i < 16; ++i) xch[(dvb * 16 + i) * 64 + lane] = o[dvb][i] * sc;
    }
    __syncthreads();
    if (map == 0) {
        float ss = 0.f;
#pragma unroll
        for (int dvb = 0; dvb < 4; ++dvb)
#pragma unroll
        for (int i = 0; i < 16; ++i) { const float v = o[dvb][i] * inv - xch[(dvb * 16 + i) * 64 + lane]; o[dvb][i] = v; ss += v * v; }
        ss = swap_sum(ss);
        const float r = __builtin_amdgcn_rsqf(ss * (1.f / 128.f) + EPS) * 0.8f;
        asm volatile("s_waitcnt lgkmcnt(0)" ::: "memory");
        char* stg = (char*)xch;
#pragma unroll
        for (int dvb = 0; dvb < 4; ++dvb)
#pragma unroll
        for (int ig = 0; ig < 4; ++ig) {
            const int dv = 32 * dvb + 8 * ig + 4 * hi;
            u32x2 w; w.x = pk2(o[dvb][4 * ig] * r, o[dvb][4 * ig + 1] * r); w.y = pk2(o[dvb][4 * ig + 2] * r, o[dvb][4 * ig + 3] * r);
            *(u32x2*)(stg + r32 * 272 + dv * 2) = w;
        }
        asm volatile("s_waitcnt lgkmcnt(0)" ::: "memory");
        const float* sg = p.in[11];
        const bf16_t* SGB = (const bf16_t*)(p.ws + WS_SGB); bf16_t* Y = (bf16_t*)(p.ws + WS_Y);
#pragma unroll
        for (int k = 0; k < 8; ++k) {
            const int id = lane + 64 * k, q = id >> 4, c = id & 15;
            const u32x4 v = *(const u32x4*)(stg + q * 272 + c * 16);
            const size_t token = (size_t)b * SEQ + qrow0 + q; const int col = h * 128 + c * 8;
            const u32x4 gb = *(const u32x4*)(SGB + token * 1024 + col);
            const f32x4 g0 = *(const f32x4*)(sg + c * 8), g1 = *(const f32x4*)(sg + c * 8 + 4);
            u32x4 w;
            w.x = pk2(bflo(v.x) * g0.x * silu_f(bflo(gb.x)), bfhi(v.x) * g0.y * silu_f(bfhi(gb.x)));
            w.y = pk2(bflo(v.y) * g0.z * silu_f(bflo(gb.y)), bfhi(v.y) * g0.w * silu_f(bfhi(gb.y)));
            w.z = pk2(bflo(v.z) * g1.x * silu_f(bflo(gb.z)), bfhi(v.z) * g1.y * silu_f(bfhi(gb.z)));
            w.w = pk2(bflo(v.w) * g1.z * silu_f(bflo(gb.w)), bfhi(v.w) * g1.w * silu_f(bfhi(gb.w)));
            *(u32x4*)(Y + token * 2048 + 1024 + col) = w;
        }
    }
    __syncthreads();
}

DI void p4_final_rows(const float* x, const bf16_t* dl, float* out, const float* g, int gw, int nw, int lane) {
    for (int row = gw; row < MTOK; row += nw) {
        const f32x4* xr = (const f32x4*)(x + (size_t)row * DM) + lane;
        const u32x2* dr = (const u32x2*)(dl + (size_t)row * DM) + lane;
        f32x4 v[8]; float s = 0.f;
#pragma unroll
        for (int j = 0; j < 8; ++j) { const f32x4 xv = xr[64 * j]; const u32x2 d2 = dr[64 * j];
            v[j].x = xv.x + bflo(d2.x); v[j].y = xv.y + bfhi(d2.x); v[j].z = xv.z + bflo(d2.y); v[j].w = xv.w + bfhi(d2.y);
            s += (v[j].x * v[j].x + v[j].y * v[j].y) + (v[j].z * v[j].z + v[j].w * v[j].w); }
        s = wave_sum(s);
        const float rstd = __builtin_amdgcn_rsqf(s * (1.0f / DM) + EPS);
        f32x4* ow = (f32x4*)(out + (size_t)row * DM) + lane;
#pragma unroll
        for (int j = 0; j < 8; ++j) { const f32x4 gg = ((const f32x4*)g)[lane + 64 * j]; ow[64 * j] = v[j] * rstd * gg; }
    }
}

__global__ __launch_bounds__(NTHREADS, 2) void hymba_mega(Params p) {
    extern __shared__ __attribute__((aligned(16))) char lds[];
    cg::grid_group grid = cg::this_grid();
    const int tid = threadIdx.x, lane = tid & 63, wid = __builtin_amdgcn_readfirstlane(tid >> 6);
    const int bid = blockIdx.x, G = gridDim.x;
    const int gw = bid * 8 + wid, nw = G * 8;

    {
#if PROBE_REP == 1
    p0_rmsnorm_rows(p.in[0], p.in[1], (bf16_t*)(p.ws + WS_H), gw, nw, lane);
#endif
    p0_rmsnorm_rows(p.in[0], p.in[1], (bf16_t*)(p.ws + WS_H), gw, nw, lane);
    {
        float* scr = (float*)lds + wid * (64 * 33);
        const int n1 = (DM / 64) * (DIN / 32), n2 = (DM / 64) * (DM / 32);
        for (int it = gw; it < n1 + n2; it += nw) {
            if (it < n1) p0_transpose_item(p.in[2], DM, DIN, (bf16_t*)(p.ws + WS_WIN), scr, it, lane);
            else p0_transpose_item(p.in[13], DM, DM, (bf16_t*)(p.ws + WS_WOUT), scr, it - n1, lane);
        }
    }
    }
    grid.sync();

    {
#if PROBE_REP == 2
        gemm_phase<0>((lds_ptr)lds, (const bf16_t*)(p.ws + WS_H), (const bf16_t*)(p.ws + WS_WIN), DM, MTOK / BM, DIN / BM, bid, G, p, wid);
#endif
        gemm_phase<0>((lds_ptr)lds, (const bf16_t*)(p.ws + WS_H), (const bf16_t*)(p.ws + WS_WIN), DM, MTOK / BM, DIN / BM, bid, G, p, wid);
    }
    grid.sync();

    {
        int tid2 = fresh_tid(wid);
        const int tid = tid2, lane = tid & 63;
        for (int rep_ = 0; rep_ < (PROBE_REP == 3 ? 2 : 1); ++rep_)
        for (int item = bid; item < 256; item += G) sgu_item(p, item, lds, tid, lane, wid);
        const int tidA = fresh_tid(wid), laneA = tidA & 63;
        float lam;
        { const float a = wave_sum(p.in[7][laneA] * p.in[8][laneA]), c = wave_sum(p.in[9][laneA] * p.in[10][laneA]); lam = __uint_as_float(__builtin_amdgcn_readfirstlane(__float_as_uint(__expf(a) - __expf(c) + 0.2f))); }
        for (int rep_ = 0; rep_ < (PROBE_REP == 4 ? 2 : 1); ++rep_)
        for (int it = bid; it < 1024; it += G) {
            const int xcd = it & 7, rest = it >> 3;
            const int bh = xcd * 2 + (rest >> 6), j = rest & 63;
            attn_unit(p, bh, 127 - j, lds, lam, tidA, laneA, wid, true);
            attn_unit(p, bh, j, lds, lam, tidA, laneA, wid, false);
        }
    }
    grid.sync();

    {
#if PROBE_REP == 5
        gemm_phase<1>((lds_ptr)lds, (const bf16_t*)(p.ws + WS_Y), (const bf16_t*)(p.ws + WS_WOUT), DM, MTOK / BM, DM / BM, bid, G, p, wid);
#endif
        gemm_phase<1>((lds_ptr)lds, (const bf16_t*)(p.ws + WS_Y), (const bf16_t*)(p.ws + WS_WOUT), DM, MTOK / BM, DM / BM, bid, G, p, wid);
    }
    grid.sync();

    {
        const int t4 = fresh_tid(wid);
        p4_final_rows(p.in[0], (const bf16_t*)(p.ws + WS_H), p.out, p.in[14], bid * 8 + wid, nw, t4 & 63);
    }
}

extern "C" void kernel_launch(void* const* d_in, const int* in_sizes, int n_in, void* d_out, int out_size, void* d_ws, size_t ws_size, hipStream_t stream) {
    static int grid_blocks = 0;
    if (grid_blocks == 0) {
        if (n_in != 15 || ws_size < WS_END) { fprintf(stderr, "kernel_launch: unexpected n_in %d / ws_size %zu\n", n_in, ws_size); grid_blocks = -1; return; }
        int dev = 0, cus = 0, per_cu = 0;
        hipGetDevice(&dev);
        hipDeviceGetAttribute(&cus, hipDeviceAttributeMultiprocessorCount, dev);
        if (hipFuncSetAttribute((const void*)hymba_mega, hipFuncAttributeMaxDynamicSharedMemorySize, LDS_BYTES) != hipSuccess) fprintf(stderr, "kernel_launch: hipFuncSetAttribute failed\n");
        if (hipOccupancyMaxActiveBlocksPerMultiprocessor(&per_cu, (const void*)hymba_mega, NTHREADS, LDS_BYTES) != hipSuccess || per_cu < 1) { fprintf(stderr, "kernel_launch: occupancy query gave %d\n", per_cu); per_cu = 1; }
        (void)hipGetLastError();
        grid_blocks = cus * 1;
    }
    if (grid_blocks < 0) return;
    Params p{};
    for (int i = 0; i < 15; ++i) p.in[i] = (const float*)d_in[i];
    p.out = (float*)d_out; p.ws = (char*)d_ws;
    void* args[] = {&p};
    hipError_t e = hipLaunchCooperativeKernel((const void*)hymba_mega, dim3(grid_blocks), dim3(NTHREADS), args, LDS_BYTES, stream);
    if (e != hipSuccess) fprintf(stderr, "cooperative launch failed: %s (grid %d)\n", hipGetErrorString(e), grid_blocks);
}
```

```cpp
#include <hip/hip_runtime.h>
#include <hip/hip_cooperative_groups.h>
#include <cstdio>
#include <cstdint>
namespace cg = cooperative_groups;

#define DI __device__ __forceinline__
typedef unsigned short bf16_t;
using bf16x8 = __attribute__((ext_vector_type(8))) short;
using s16x4  = __attribute__((ext_vector_type(4))) short;
using f32x4  = __attribute__((ext_vector_type(4))) float;
using f32x16 = __attribute__((ext_vector_type(16))) float;
using u32x4  = __attribute__((ext_vector_type(4))) unsigned;
using u32x2  = __attribute__((ext_vector_type(2))) unsigned;
typedef short v4i16_t __attribute__((ext_vector_type(4)));
typedef __attribute__((address_space(3))) const char* lds_cptr;

constexpr int MTOK = 32768, SEQ = 16384, DM = 2048, DIN = 7168;
constexpr float EPS = 1e-6f;
constexpr float LOG2E = 1.4426950408889634f;
constexpr int NTHREADS = 512;
constexpr int LDS_BYTES = 131072;
#ifndef PHASE_MASK
#define PHASE_MASK 31
#endif
#ifndef PROBE_REP
#define PROBE_REP 0
#endif
#ifndef ATT_STAGGER
#define ATT_STAGGER 0
#endif

constexpr size_t SZ_H = (size_t)MTOK * DM * 2;
constexpr size_t SZ_WIN = (size_t)DIN * DM * 2;
constexpr size_t SZ_WOUT = (size_t)DM * DM * 2;
constexpr size_t SZ_SEG = (size_t)MTOK * 1024 * 2;
constexpr size_t WS_H = 0;
constexpr size_t WS_WIN = WS_H + SZ_H;
constexpr size_t WS_WOUT = WS_WIN + SZ_WIN;
constexpr size_t WS_U = WS_WOUT + SZ_WOUT;
constexpr size_t WS_GV = WS_U + SZ_SEG;
constexpr size_t WS_SGA = WS_GV + SZ_SEG;
constexpr size_t WS_SGB = WS_SGA + SZ_SEG;
constexpr size_t WS_Q = WS_SGB + SZ_SEG;
constexpr size_t WS_K = WS_Q + SZ_SEG;
constexpr size_t WS_V = WS_K + SZ_SEG;
constexpr size_t WS_Y = WS_V + SZ_SEG;
constexpr size_t WS_END = WS_Y + SZ_H;

struct Params {
    const float* in[15];
    float* out;
    char* ws;
};

typedef __bf16 bf16x2_t __attribute__((ext_vector_type(2)));
typedef float f32x2_t __attribute__((ext_vector_type(2)));
DI unsigned pk2(float lo, float hi) { f32x2_t v = {lo, hi}; bf16x2_t b = __builtin_convertvector(v, bf16x2_t); return __builtin_bit_cast(unsigned, b); }
DI float bflo(unsigned u) { return __uint_as_float(u << 16); }
DI float bfhi(unsigned u) { return __uint_as_float(u & 0xffff0000u); }
DI float wave_sum(float v) {
#pragma unroll
    for (int o = 1; o < 64; o <<= 1) v += __shfl_xor(v, o);
    return v;
}
DI float ex2(float x) { return __builtin_amdgcn_exp2f(x); }
DI int fresh_tid(int wid) { int z = 0; asm volatile("" : "+v"(z)); return wid * 64 + (int)__builtin_amdgcn_mbcnt_hi(~0u, __builtin_amdgcn_mbcnt_lo(~0u, (unsigned)z)); }
DI float gelu_f(float x) {
    const float c1 = 2.0f * 0.7978845608028654f * LOG2E, c2 = c1 * 0.044715f;
    const float z = x * (c1 + c2 * x * x);
    return x * __builtin_amdgcn_rcpf(1.0f + ex2(-z));
}
DI float silu_f(float x) { return x * __builtin_amdgcn_rcpf(1.0f + ex2(-x * LOG2E)); }
DI float swap_max(float m) { auto rr = __builtin_amdgcn_permlane32_swap(__float_as_uint(m), __float_as_uint(m), false, false); return __builtin_fmaxf(__uint_as_float(rr[0]), __uint_as_float(rr[1])); }
DI float swap_sum(float m) { auto rr = __builtin_amdgcn_permlane32_swap(__float_as_uint(m), __float_as_uint(m), false, false); return __uint_as_float(rr[0]) + __uint_as_float(rr[1]); }
DI s16x4 vtr(lds_cptr p) { return __builtin_bit_cast(s16x4, __builtin_amdgcn_ds_read_tr16_b64_v4i16((__attribute__((address_space(3))) v4i16_t*)p)); }
#define MFMA32(a, b, c) __builtin_amdgcn_mfma_f32_32x32x16_bf16((a), (b), (c), 0, 0, 0)
#define MFMA16(a, b, c) __builtin_amdgcn_mfma_f32_16x16x32_bf16((a), (b), (c), 0, 0, 0)

DI void p0_rmsnorm_rows(const float* x, const float* g, bf16_t* h, int gw, int nw, int lane) {
    for (int row = gw; row < MTOK; row += nw) {
        const f32x4* xr = (const f32x4*)(x + (size_t)row * DM) + lane;
        f32x4 v[8]; float s = 0.f;
#pragma unroll
        for (int j = 0; j < 8; ++j) { v[j] = __builtin_nontemporal_load(xr + 64 * j); s += (v[j].x * v[j].x + v[j].y * v[j].y) + (v[j].z * v[j].z + v[j].w * v[j].w); }
        s = wave_sum(s);
        const float rstd = __builtin_amdgcn_rsqf(s * (1.0f / DM) + EPS);
        u32x2* o8 = (u32x2*)(h + (size_t)row * DM) + lane;
#pragma unroll
        for (int j = 0; j < 8; ++j) {
            const f32x4 gg = ((const f32x4*)g)[lane + 64 * j];
            u32x2 o; o.x = pk2(v[j].x * rstd * gg.x, v[j].y * rstd * gg.y); o.y = pk2(v[j].z * rstd * gg.z, v[j].w * rstd * gg.w);
            o8[64 * j] = o;
        }
    }
}
DI void p0_transpose_item(const float* W, int K, int N, bf16_t* WT, float* scr, int item, int lane) {
    const int nblk = N / 32, kb = item / nblk, nb = item % nblk, k0 = 64 * kb, n0 = 32 * nb;
#pragma unroll 8
    for (int i = 0; i < 32; ++i) { const int kk = 2 * i + (lane >> 5); scr[kk * 33 + (lane & 31)] = W[(size_t)(k0 + kk) * N + n0 + (lane & 31)]; }
    asm volatile("s_waitcnt vmcnt(0) lgkmcnt(0)" ::: "memory");
    const int c = lane & 7;
#pragma unroll
    for (int j = 0; j < 4; ++j) {
        const int n = (lane >> 3) + 8 * j; const float* s = scr + (8 * c) * 33 + n;
        u32x4 o; o.x = pk2(s[0], s[33]); o.y = pk2(s[66], s[99]); o.z = pk2(s[132], s[165]); o.w = pk2(s[198], s[231]);
        *(u32x4*)(WT + (size_t)(n0 + n) * K + k0 + 8 * c) = o;
    }
    asm volatile("s_waitcnt lgkmcnt(0)" ::: "memory");
}

constexpr int BM = 256, BK = 64, HALF = 128, HT = HALF * BK;
DI int lds_byte(int r, int c) { int st = (r >> 4) * 2 + (c >> 5), rr = r & 15, cc = c & 31, ob = rr * 64 + cc * 2; return st * 1024 + (ob ^ (((ob >> 9) & 1) << 5)); }
DI void stage_rc(int b, int& R, int& C) { int st = b / 1024, sb = b % 1024, swz = sb ^ (((sb >> 9) & 1) << 5); R = (st >> 1) * 16 + swz / 64; C = (st & 1) * 32 + (swz % 64) / 2; }

DI void tile_order(int L, int nM, int nN, int& pm, int& pn) {
    const int nwg = nM * nN; int wgid = L;
    { const int q = nwg / 8, r = nwg % 8, xcd = wgid % 8, off = wgid / 8; wgid = (xcd < r ? xcd * (q + 1) : r * (q + 1) + (xcd - r) * q) + off; }
    const int nig = 8 * nN, gid = wgid / nig, fm = gid * 8, gsz = (nM - fm) < 8 ? (nM - fm) : 8;
    pm = fm + ((wgid % nig) % gsz); pn = (wgid % nig) / gsz;
}

typedef __attribute__((address_space(3))) unsigned char* lds_ptr;
template <int EPI>
DI void gemm_epilogue(const f32x4 (&acc)[2][2][4][2], const int brow, const int bcol, const int wr, const int wc, const int fr, const int fq, const Params& p) {
    if (EPI == 0) {
        const int seg = bcol >> 10;
        bf16_t* segbase = (bf16_t*)(p.ws + (seg == 0 ? WS_U : seg == 1 ? WS_GV : seg == 2 ? WS_SGA : seg == 3 ? WS_Q : seg == 4 ? WS_K : seg == 5 ? WS_V : WS_SGB));
        const int c8 = (fq & 1) ? 16 + 4 * (fq - 1) : 4 * fq;
#pragma unroll 1
        for (int ai = 0; ai < 2; ++ai)
#pragma unroll
        for (int m = 0; m < 4; ++m) {
            const int row = brow + ai * HALF + wr * 64 + m * 16 + fr;
            const int bb = row >> 14, s = row & (SEQ - 1);
#pragma unroll
            for (int bj = 0; bj < 2; ++bj) {
                u32x2 og[2];
#pragma unroll
                for (int n = 0; n < 2; ++n) {
                    f32x4 v = ai == 0 ? acc[0][bj][m][n] : acc[1][bj][m][n];
                    if (seg <= 1) { v.x = gelu_f(v.x); v.y = gelu_f(v.y); v.z = gelu_f(v.z); v.w = gelu_f(v.w); }
                    else if (seg == 2 || seg == 6) { v.x = silu_f(v.x); v.y = silu_f(v.y); v.z = silu_f(v.z); v.w = silu_f(v.w); }
                    else if (seg == 3) { const float sc = 0.125f * LOG2E; v.x *= sc; v.y *= sc; v.z *= sc; v.w *= sc; }
                    og[n].x = pk2(v.x, v.y); og[n].y = pk2(v.z, v.w);
                }
                const auto rx = __builtin_amdgcn_permlane16_swap(og[0].x, og[1].x, false, false);
                const auto ry = __builtin_amdgcn_permlane16_swap(og[0].y, og[1].y, false, false);
                u32x4 o; o.x = rx[0]; o.y = ry[0]; o.z = rx[1]; o.w = ry[1];
                const int col = (bcol & 1023) + bj * HALF + wc * 32 + c8;
                size_t idx;
                if (seg <= 2 || seg == 6) idx = (size_t)row * 1024 + col;
                else if (seg == 3) { const int hh = col >> 7, mp = (col >> 6) & 1, d = col & 63; idx = ((size_t)((bb * 8 + hh) * 2 + mp) * SEQ + s) * 64 + d; }
                else if (seg == 4) { const int hh = col >> 7, mp = (col >> 6) & 1, d = col & 63;
                    idx = ((((size_t)(bb * 8 + hh) * 256 + (s >> 6)) * 2 + mp) * 8 + (d >> 3)) * 512 + (size_t)(s & 63) * 8; }
                else { const int hh = col >> 7, dv = col & 127;
                    idx = (((size_t)(bb * 8 + hh) * 256 + (s >> 6)) * 4 + (dv >> 5)) * 2048 + (size_t)(s & 63) * 32 + (dv & 31); }
                *(u32x4*)(segbase + idx) = o;
            }
        }
    } else {
        bf16_t* dl = (bf16_t*)(p.ws + WS_H);
        const int c8 = (fq & 1) ? 16 + 4 * (fq - 1) : 4 * fq;
#pragma unroll
        for (int ai = 0; ai < 2; ++ai)
#pragma unroll
        for (int m = 0; m < 4; ++m) {
            const int row = brow + ai * HALF + wr * 64 + m * 16 + fr;
#pragma unroll
            for (int bj = 0; bj < 2; ++bj) {
                u32x2 og[2];
#pragma unroll
                for (int n = 0; n < 2; ++n) { const f32x4 v = acc[ai][bj][m][n]; og[n].x = pk2(v.x, v.y); og[n].y = pk2(v.z, v.w); }
                const auto rx = __builtin_amdgcn_permlane16_swap(og[0].x, og[1].x, false, false);
                const auto ry = __builtin_amdgcn_permlane16_swap(og[0].y, og[1].y, false, false);
                u32x4 o; o.x = rx[0]; o.y = ry[0]; o.z = rx[1]; o.w = ry[1];
                const int col = bcol + bj * HALF + wc * 32 + c8;
                *(u32x4*)(dl + (size_t)row * DM + col) = o;
            }
        }
    }
}

template <int EPI>
DI void gemm_phase(lds_ptr lds, const bf16_t* __restrict__ Ag, const bf16_t* __restrict__ Btg, const int K, const int nM, const int nN, const int bid, const int G, const Params& p, const int wid0) {
    int tid_l = fresh_tid(wid0);
    const int tid = tid_l, wid = __builtin_amdgcn_readfirstlane(tid >> 6), lane = tid & 63, wr = wid >> 2, wc = wid & 3, fr = lane & 15, fq = lane >> 4;
    const int nt = K / BK, nunits = nM * nN;
    constexpr int HTB = HALF * BK * 2;
    unsigned voff[2];
#pragma unroll
    for (int i = 0; i < 2; ++i) { int R, C; stage_rc(tid * 16 + i * 8192, R, C); voff[i] = (unsigned)(R * K + C) * 2u; }
    const size_t kstep = (size_t)(BK * 2), hstep = (size_t)HALF * K * 2, tstep = 2 * hstep;
    const unsigned ldsw = (unsigned)wid * 1024u;
    const int aoff = lds_byte(wr * 64 + fr, fq * 8), boff = lds_byte(wc * 32 + fr, fq * 8);
#define SAo(b, h) (((b) * 2 + (h)) * HTB)
#define SBo(b, h) ((4 + (b) * 2 + (h)) * HTB)
#define STAGE(bufoff, gbase) do { _Pragma("unroll") for (int _i = 0; _i < 2; ++_i) \
        __builtin_amdgcn_global_load_lds((const __attribute__((address_space(1))) unsigned*)((const char*)(gbase) + voff[_i]), (__attribute__((address_space(3))) unsigned*)(lds + (bufoff) + ldsw + _i * 8192), 16, 0, 0); } while (0)
#define LDA(dst, b, h) do { _Pragma("unroll") for (int m = 0; m < 4; ++m) _Pragma("unroll") for (int k = 0; k < 2; ++k) dst[m][k] = *(const __attribute__((address_space(3))) bf16x8*)(lds + SAo(b, h) + aoff + m * 2048 + k * 1024); } while (0)
#define LDB(dst, b, h) do { _Pragma("unroll") for (int n = 0; n < 2; ++n) _Pragma("unroll") for (int k = 0; k < 2; ++k) dst[n][k] = *(const __attribute__((address_space(3))) bf16x8*)(lds + SBo(b, h) + boff + n * 2048 + k * 1024); } while (0)
#define MMA(ai, bj, At_, Bt_) do { __builtin_amdgcn_s_setprio(1); _Pragma("unroll") for (int m = 0; m < 4; ++m) _Pragma("unroll") for (int n = 0; n < 2; ++n) _Pragma("unroll") for (int k = 0; k < 2; ++k) \
        acc[ai][bj][m][n] = MFMA16(Bt_[n][k], At_[m][k], acc[ai][bj][m][n]); __builtin_amdgcn_s_setprio(0); } while (0)
#define WAIT_V(n) asm volatile("s_waitcnt vmcnt(" #n ")" ::: "memory")
#define WAIT_L(n) asm volatile("s_waitcnt lgkmcnt(" #n ")" ::: "memory")
#define BAR __builtin_amdgcn_s_barrier()
#define SCHED __builtin_amdgcn_sched_barrier(0)
    if (bid >= nunits) return;
    int ui = 0, cpm, cpn, npm = 0, npn = 0;
    tile_order(bid, nM, nN, cpm, cpn);
    f32x4 acc[2][2][4][2];
#pragma unroll
    for (int a = 0; a < 2; ++a)
#pragma unroll
        for (int b = 0; b < 2; ++b)
#pragma unroll
            for (int m = 0; m < 4; ++m)
#pragma unroll
                for (int n = 0; n < 2; ++n) acc[a][b][m][n] = (f32x4){0.f, 0.f, 0.f, 0.f};
    bf16x8 At[4][2], B0[2][2], B1[2][2];
    const char* cA = (const char*)Ag + (size_t)cpm * tstep; const char* cB = (const char*)Btg + (size_t)cpn * tstep;
    STAGE(SBo(0, 0), cB); STAGE(SAo(0, 0), cA); STAGE(SBo(0, 1), cB + hstep); STAGE(SAo(0, 1), cA + hstep);
    if (wr == 1) BAR;
    WAIT_V(4); BAR;
    STAGE(SBo(1, 0), cB + kstep); STAGE(SAo(1, 0), cA + kstep); STAGE(SBo(1, 1), cB + hstep + kstep);
    WAIT_V(6); BAR;
    for (;;) {
        const bool has_next = (ui + 1) * G + bid < nunits;
        if (has_next) tile_order((ui + 1) * G + bid, nM, nN, npm, npn);
        const char* nA = has_next ? (const char*)Ag + (size_t)npm * tstep : cA; const char* nB = has_next ? (const char*)Btg + (size_t)npn * tstep : cB;
        for (int t = 0; t < nt; t += 2) {
            const bool last = (t == nt - 2);
            const char* a1 = cA + (size_t)(t + 1) * kstep;
            const char* a2 = last ? nA : cA + (size_t)(t + 2) * kstep; const char* b2 = last ? nB : cB + (size_t)(t + 2) * kstep;
            const char* a3 = a2 + kstep; const char* b3 = b2 + kstep;
            LDB(B0, 0, 0); SCHED; LDA(At, 0, 0); STAGE(SAo(1, 1), a1 + hstep);
            WAIT_L(8); BAR; WAIT_L(0); MMA(0, 0, At, B0); BAR; SCHED;
            LDB(B1, 0, 1); STAGE(SBo(0, 0), b2);
            BAR; WAIT_L(0); MMA(0, 1, At, B1); BAR;
            LDA(At, 0, 1); STAGE(SAo(0, 0), a2);
            BAR; WAIT_L(0); MMA(1, 0, At, B0); BAR; SCHED;
            STAGE(SBo(0, 1), b2 + hstep);
            WAIT_V(6); BAR; MMA(1, 1, At, B1); BAR;
            LDB(B0, 1, 0); SCHED; LDA(At, 1, 0); STAGE(SAo(0, 1), a2 + hstep);
            WAIT_L(8); BAR; WAIT_L(0); MMA(0, 0, At, B0); BAR; SCHED;
            LDB(B1, 1, 1); STAGE(SBo(1, 0), b3);
            BAR; WAIT_L(0); MMA(0, 1, At, B1); BAR;
            LDA(At, 1, 1); STAGE(SAo(1, 0), a3);
            BAR; WAIT_L(0); MMA(1, 0, At, B0); BAR; SCHED;
            STAGE(SBo(1, 1), b3 + hstep);
            WAIT_V(6); BAR; MMA(1, 1, At, B1); BAR;
        }
        gemm_epilogue<EPI>(acc, cpm * BM, cpn * BM, wr, wc, fr, fq, p);
        if (!has_next) break;
#pragma unroll
        for (int a = 0; a < 2; ++a)
#pragma unroll
            for (int b = 0; b < 2; ++b)
#pragma unroll
                for (int m = 0; m < 4; ++m)
#pragma unroll
                    for (int n = 0; n < 2; ++n) acc[a][b][m][n] = (f32x4){0.f, 0.f, 0.f, 0.f};
        cpm = npm; cpn = npn; cA = nA; cB = nB; ++ui;
    }
    WAIT_V(0);
    if (wr == 0) BAR;
    BAR;
#undef SAo
#undef SBo
#undef STAGE
#undef LDA
#undef LDB
#undef MMA
}

DI void sgu_item(const Params& p, int item, char* lds, int tid, int lane, int wid) {
    const int r0 = item * 128, r32 = lane & 31, hi = lane >> 5;
    const bf16_t* GV = (const bf16_t*)(p.ws + WS_GV); const bf16_t* U = (const bf16_t*)(p.ws + WS_U); const bf16_t* SGA = (const bf16_t*)(p.ws + WS_SGA);
    bf16_t* Y = (bf16_t*)(p.ws + WS_Y);
    float* stats = (float*)(lds + 98304);
#pragma unroll 1
    for (int rb = 0; rb < 16; rb += 8) {
        u32x4 a[8], b2[8];
#pragma unroll
        for (int rr = 0; rr < 8; ++rr) { const u32x4* src = (const u32x4*)(GV + (size_t)(r0 + 16 * wid + rb + rr) * 1024); a[rr] = src[lane]; b2[rr] = src[lane + 64]; }
#pragma unroll
        for (int rr = 0; rr < 8; ++rr) {
            float s = 0.f, ss = 0.f;
#pragma unroll
            for (int e = 0; e < 4; ++e) { float f0 = bflo(a[rr][e]), f1 = bfhi(a[rr][e]), f2 = bflo(b2[rr][e]), f3 = bfhi(b2[rr][e]); s += (f0 + f1) + (f2 + f3); ss += (f0 * f0 + f1 * f1) + (f2 * f2 + f3 * f3); }
            s = wave_sum(s); ss = wave_sum(ss);
            if (lane == 0) { const float mean = s * (1.f / 1024.f); const float var = ss * (1.f / 1024.f) - mean * mean; stats[(16 * wid + rb + rr) * 2] = mean; stats[(16 * wid + rb + rr) * 2 + 1] = __builtin_amdgcn_rsqf(var + EPS); }
        }
    }
    __syncthreads();
    const float* lng = p.in[3]; const float* lnb = p.in[4]; const float* sw = p.in[5]; const float* sb = p.in[6];
    const int tb = wid & 3, ch = wid >> 2, t = tb * 32 + r32;
    for (int g = 0; g < 8; ++g) {
#pragma unroll
        for (int i = 0; i < 4; ++i) {
            const int q = tid + 512 * i, s = q >> 4, cc = q & 15;
            const u32x4 raw = *(const u32x4*)(GV + (size_t)(r0 + s) * 1024 + g * 128 + cc * 8);
            const float mean = stats[2 * s], rstd = stats[2 * s + 1];
            const f32x4 g0 = *(const f32x4*)(lng + g * 128 + cc * 8), g1 = *(const f32x4*)(lng + g * 128 + cc * 8 + 4);
            const f32x4 b0 = *(const f32x4*)(lnb + g * 128 + cc * 8), b1 = *(const f32x4*)(lnb + g * 128 + cc * 8 + 4);
            u32x4 o;
            o.x = pk2((bflo(raw.x) - mean) * rstd * g0.x + b0.x, (bfhi(raw.x) - mean) * rstd * g0.y + b0.y);
            o.y = pk2((bflo(raw.y) - mean) * rstd * g0.z + b0.z, (bfhi(raw.y) - mean) * rstd * g0.w + b0.w);
            o.z = pk2((bflo(raw.z) - mean) * rstd * g1.x + b1.x, (bfhi(raw.z) - mean) * rstd * g1.y + b1.y);
            o.w = pk2((bflo(raw.w) - mean) * rstd * g1.z + b1.z, (bfhi(raw.w) - mean) * rstd * g1.w + b1.w);
            *(u32x4*)(lds + (cc >> 2) * 8192 + s * 64 + (cc & 3) * 16) = o;
        }
        __syncthreads();
        f32x16 d[2]; d[0] = f32x16{}; d[1] = f32x16{};
        const float* wrow = sw + ((size_t)g * 128 + t) * 128;
        const lds_cptr vp = (lds_cptr)lds + ((lane >> 4) & 1) * 32 + (lane & 3) * 8 + ((lane & 15) >> 2) * 64;
#pragma unroll
        for (int ks = 0; ks < 8; ++ks) {
            const int s0 = 16 * ks + 8 * hi;
            f32x4 w0 = *(const f32x4*)(wrow + s0), w1 = *(const f32x4*)(wrow + s0 + 4);
            if ((s0 >> 6) > (t >> 6)) { w0 = f32x4{0.f, 0.f, 0.f, 0.f}; w1 = w0; }
            u32x4 wp; wp.x = pk2(w0.x, w0.y); wp.y = pk2(w0.z, w0.w); wp.z = pk2(w1.x, w1.y); wp.w = pk2(w1.z, w1.w);
            const bf16x8 wf = __builtin_bit_cast(bf16x8, wp);
#pragma unroll
            for (int cbi = 0; cbi < 2; ++cbi) {
                const int cb = 2 * ch + cbi;
                const s16x4 lo = vtr(vp + cb * 8192 + s0 * 64), hi4 = vtr(vp + cb * 8192 + (s0 + 4) * 64);
                const bf16x8 vf = __builtin_shufflevector(lo, hi4, 0, 1, 2, 3, 4, 5, 6, 7);
                d[cbi] = MFMA32(vf, wf, d[cbi]);
            }
            if (ks & 1) __builtin_amdgcn_sched_barrier(0);
        }
        const float bs = sb[g * 128 + t];
        char* stg = lds + 32768;
#pragma unroll
        for (int cbi = 0; cbi < 2; ++cbi)
#pragma unroll
        for (int ig = 0; ig < 4; ++ig) {
            const int cl = (2 * ch + cbi) * 32 + 8 * ig + 4 * hi;
            u32x2 o; o.x = pk2(d[cbi][4 * ig] + bs, d[cbi][4 * ig + 1] + bs); o.y = pk2(d[cbi][4 * ig + 2] + bs, d[cbi][4 * ig + 3] + bs);
            *(u32x2*)(stg + t * 272 + cl * 2) = o;
        }
        __syncthreads();
#pragma unroll
        for (int i = 0; i < 4; ++i) {
            const int q = tid + 512 * i, r = q >> 4, cc = q & 15;
            const u32x4 mx = *(const u32x4*)(stg + r * 272 + cc * 16);
            const size_t rw = (size_t)(r0 + r); const int c = g * 128 + cc * 8;
            const u32x4 uu = *(const u32x4*)(U + rw * 1024 + c), gg = *(const u32x4*)(SGA + rw * 1024 + c);
            u32x4 o;
            o.x = pk2(bflo(uu.x) * bflo(mx.x) * bflo(gg.x), bfhi(uu.x) * bfhi(mx.x) * bfhi(gg.x));
            o.y = pk2(bflo(uu.y) * bflo(mx.y) * bflo(gg.y), bfhi(uu.y) * bfhi(mx.y) * bfhi(gg.y));
            o.z = pk2(bflo(uu.z) * bflo(mx.z) * bflo(gg.z), bfhi(uu.z) * bfhi(mx.z) * bfhi(gg.z));
            o.w = pk2(bflo(uu.w) * bflo(mx.w) * bflo(gg.w), bfhi(uu.w) * bfhi(mx.w) * bfhi(gg.w));
            *(u32x4*)(Y + rw * 2048 + c) = o;
        }
    }
    __syncthreads();
}

DI int t5_bucket_dev(int rel) {
    const int side = rel > 0 ? 16 : 0; const int n = rel < 0 ? -rel : rel;
    int v;
    if (n < 8) v = n; else if (n < 12) v = 8; else if (n < 16) v = 9; else if (n < 23) v = 10; else if (n < 32) v = 11; else if (n < 46) v = 12; else if (n < 64) v = 13; else if (n < 91) v = 14; else v = 15;
    return side + v;
}

DI void attn_unit(const Params& p, int bh, int qb, char* lds, float lam, int tid, int lane, int wid, const bool build_tab) {
    const int h = bh & 7, b = bh >> 3;
    const int map = wid & 1, qblk = wid >> 1, r32 = lane & 31, hi = lane >> 5;
    const int NT = 2 * qb + 2, ntw = 2 * qb + 1 + (qblk >> 1);
    float* tab = (float*)(lds + 98304);
    const char* KGc = p.ws + WS_K + ((size_t)bh * 256 << 14) + tid * 16;
    const char* VGc = p.ws + WS_V + ((size_t)bh * 256 << 14) + tid * 16;
#define GLDS16(gp_, ldsoff_) do { unsigned sv_; asm volatile("s_mov_b32 %0, m0\n\ts_mov_b32 m0, %2\n\ts_nop 0\n\tglobal_load_lds_dwordx4 %1, off\n\ts_mov_b32 m0, %0" : "=&s"(sv_) : "v"(gp_), "s"(ldsoff_) : "memory"); } while (0)
#define GLOAD(t_, slotoff_) do { const char* kb_ = KGc + ((size_t)(t_) << 14); const char* vb_ = VGc + ((size_t)(t_) << 14); \
        const unsigned d_ = (unsigned)__builtin_amdgcn_readfirstlane((int)(ldsbase + (slotoff_) + wid * 1024)); \
        GLDS16(kb_, d_); GLDS16(kb_ + 8192, d_ + 8192u); GLDS16(vb_, d_ + 16384u); GLDS16(vb_ + 8192, d_ + 24576u); } while (0)
    const unsigned ldsbase = (unsigned)(uintptr_t)(__attribute__((address_space(3))) char*)lds;
#define SCHEDB() __builtin_amdgcn_sched_barrier(0)
    const int qrow0 = 128 * qb + 32 * qblk;
    bf16x8 qf[4];
    { const bf16_t* qrow = (const bf16_t*)(p.ws + WS_Q) + ((size_t)(bh * 2 + map) * SEQ + qrow0 + r32) * 64 + hi * 8;
#pragma unroll
      for (int d0 = 0; d0 < 4; ++d0) qf[d0] = *(const bf16x8*)(qrow + 16 * d0); }
    GLOAD(0, 0);
    GLOAD(1, 32768);
    if (build_tab && tid < 320) { const float* rb = p.in[12]; const int rel = tid - 256; tab[tid] = rel < -128 ? 0.f : (rb[t5_bucket_dev(rel) * 8 + h] - rb[15 * 8 + h]) * LOG2E; }
    asm volatile("s_waitcnt vmcnt(0)" ::: "memory");
    __syncthreads();
    const bool grpB = wid >= 4;
    if (ATT_STAGGER && grpB) __builtin_amdgcn_s_barrier();
    f32x16 o[4]; o[0] = f32x16{}; o[1] = f32x16{}; o[2] = f32x16{}; o[3] = f32x16{};
    float l = 0.f, nm = 0.f;
    f32x16 cinit = f32x16{};
    int sc = 0, sn1 = 32768, sn2 = 65536;
#define LOADV(dst, ks_) do { _Pragma("unroll") for (int dvb = 0; dvb < 4; ++dvb) { dst[2 * dvb] = vtr(vp + dvb * 4096 + (ks_) * 1024); dst[2 * dvb + 1] = vtr(vp + dvb * 4096 + (ks_) * 1024 + 512); } } while (0)
#define MF4(src, pfrag) do { _Pragma("unroll") for (int dvb = 0; dvb < 4; ++dvb) { \
        const bf16x8 vf_ = __builtin_shufflevector(src[2 * dvb], src[2 * dvb + 1], 0, 1, 2, 3, 4, 5, 6, 7); o[dvb] = MFMA32(vf_, pfrag, o[dvb]); } } while (0)
#define MX3(a_, b_, c_) __builtin_fmaxf(__builtin_fmaxf((a_), (b_)), (c_))
    for (int t = 0; t < NT; ++t) {
        const bool act = t < ntw;
        const lds_cptr vp = (lds_cptr)lds + sc + 16384 + ((lane >> 4) & 1) * 32 + (lane & 3) * 8 + (4 * hi + ((lane & 15) >> 2)) * 64;
        bf16x8 pf[4]; s16x4 va[8], vb[8];
        if (act) {
            const lds_cptr kp = (lds_cptr)lds + sc + map * 8192 + hi * 1024 + r32 * 16;
            bf16x8 kf[8];
#pragma unroll
            for (int d0 = 0; d0 < 4; ++d0) {
                kf[2 * d0] = *(const __attribute__((address_space(3))) bf16x8*)(kp + d0 * 2048);
                kf[2 * d0 + 1] = *(const __attribute__((address_space(3))) bf16x8*)(kp + d0 * 2048 + 512);
            }
            f32x16 s0 = cinit, s1 = cinit;
#pragma unroll
            for (int d0 = 0; d0 < 4; ++d0) { s0 = MFMA32(kf[2 * d0], qf[d0], s0); s1 = MFMA32(kf[2 * d0 + 1], qf[d0], s1); }
            LOADV(va, 0);
            if (t >= 2 * qb - 2) {
                const float* tb = tab + (64 * t - (qrow0 + r32) + 256 + 4 * hi);
#pragma unroll
                for (int i = 0; i < 16; ++i) {
                    s0[i] += tb[(i & 3) + 8 * (i >> 2)];
                    s1[i] += tb[(i & 3) + 8 * (i >> 2) + 32];
                }
            }
            float mxa = MX3(s0[0], s0[1], s1[0]), mxb = MX3(s0[2], s0[3], s1[1]); mxa = MX3(mxa, s1[2], s1[3]);
#pragma unroll
            for (int r = 4; r < 16; r += 4) { mxa = MX3(mxa, s0[r], s0[r + 1]); mxb = MX3(mxb, s0[r + 2], s0[r + 3]); mxa = MX3(mxa, s1[r], s1[r + 1]); mxb = MX3(mxb, s1[r + 2], s1[r + 3]); }
            float mx = swap_max(__builtin_fmaxf(mxa, mxb));
            const bool first = (t == 0);
            if (first || __builtin_amdgcn_ballot_w64(mx > 8.0f) != 0ull) {
                const float dl = first ? mx : __builtin_fmaxf(mx, 0.f);
                const float f = first ? 1.0f : ex2(-dl);
                l *= f; nm -= dl;
#pragma unroll
                for (int i = 0; i < 16; ++i) { o[0][i] *= f; o[1][i] *= f; o[2][i] *= f; o[3][i] *= f; cinit[i] = nm; s0[i] -= dl; s1[i] -= dl; }
            }
            asm volatile("s_waitcnt vmcnt(0)" ::: "memory");
            if (t + 2 < NT) GLOAD(t + 2, sn2);
            float rs0 = 0.f, rs1 = 0.f;
#define EXPQ(S, lo_, RS, PF) do { _Pragma("unroll") for (int i = lo_; i < lo_ + 8; ++i) { S[i] = ex2(S[i]); RS += S[i]; } \
              u32x4 w_; w_.x = pk2(S[lo_], S[lo_ + 1]); w_.y = pk2(S[lo_ + 2], S[lo_ + 3]); w_.z = pk2(S[lo_ + 4], S[lo_ + 5]); w_.w = pk2(S[lo_ + 6], S[lo_ + 7]); PF = __builtin_bit_cast(bf16x8, w_); } while (0)
            EXPQ(s0, 0, rs0, pf[0]);
            LOADV(vb, 1);
            MF4(va, pf[0]);
            EXPQ(s0, 8, rs1, pf[1]);
            LOADV(va, 2);
            MF4(vb, pf[1]);
            EXPQ(s1, 0, rs0, pf[2]);
            LOADV(vb, 3);
            MF4(va, pf[2]);
            EXPQ(s1, 8, rs1, pf[3]);
            MF4(vb, pf[3]);
            l += rs0 + rs1;
#undef EXPQ
        } else {
            asm volatile("s_waitcnt vmcnt(0)" ::: "memory");
            if (t + 2 < NT) GLOAD(t + 2, sn2);
        }
        SCHEDB();
        __builtin_amdgcn_s_barrier();
        SCHEDB();
        { const int tmp = sc; sc = sn1; sn1 = sn2; sn2 = tmp; }
    }
#undef LOADV
#undef MF4
#undef MX3
    if (ATT_STAGGER && !grpB) __builtin_amdgcn_s_barrier();
    asm volatile("s_waitcnt vmcnt(0) lgkmcnt(0)" ::: "memory");
    __syncthreads();
#undef GLOAD
#undef SCHEDB
    const float lt = swap_sum(l);
    const float inv = __builtin_amdgcn_rcpf(lt);
    float* xch = (float*)lds + qblk * 4096;
    if (map == 1) {
        const float sc = inv * lam;
#pragma unroll
        for (int dvb = 0; dvb < 4; ++dvb)
#pragma unroll
        for (int i = 0; i < 16; ++i) xch[(dvb * 16 + i) * 64 + lane] = o[dvb][i] * sc;
    }
    __syncthreads();
    if (map == 0) {
        float ss = 0.f;
#pragma unroll
        for (int dvb = 0; dvb < 4; ++dvb)
#pragma unroll
        for (int i = 0; i < 16; ++i) { const float v = o[dvb][i] * inv - xch[(dvb * 16 + i) * 64 + lane]; o[dvb][i] = v; ss += v * v; }
        ss = swap_sum(ss);
        const float r = __builtin_amdgcn_rsqf(ss * (1.f / 128.f) + EPS) * 0.8f;
        asm volatile("s_waitcnt lgkmcnt(0)" ::: "memory");
        char* stg = (char*)xch;
#pragma unroll
        for (int dvb = 0; dvb < 4; ++dvb)
#pragma unroll
        for (int ig = 0; ig < 4; ++ig) {
            const int dv = 32 * dvb + 8 * ig + 4 * hi;
            u32x2 w; w.x = pk2(o[dvb][4 * ig] * r, o[dvb][4 * ig + 1] * r); w.y = pk2(o[dvb][4 * ig + 2] * r, o[dvb][4 * ig + 3] * r);
            *(u32x2*)(stg + r32 * 272 + dv * 2) = w;
        }
        asm volatile("s_waitcnt lgkmcnt(0)" ::: "memory");
        const float* sg = p.in[11];
        const bf16_t* SGB = (const bf16_t*)(p.ws + WS_SGB); bf16_t* Y = (bf16_t*)(p.ws + WS_Y);
#pragma unroll
        for (int k = 0; k < 8; ++k) {
            const int id = lane + 64 * k, q = id >> 4, c = id & 15;
            const u32x4 v = *(const u32x4*)(stg + q * 272 + c * 16);
            const size_t token = (size_t)b * SEQ + qrow0 + q; const int col = h * 128 + c * 8;
            const u32x4 gb = *(const u32x4*)(SGB + token * 1024 + col);
            const f32x4 g0 = *(const f32x4*)(sg + c * 8), g1 = *(const f32x4*)(sg + c * 8 + 4);
            u32x4 w;
            w.x = pk2(bflo(v.x) * g0.x * bflo(gb.x), bfhi(v.x) * g0.y * bfhi(gb.x));
            w.y = pk2(bflo(v.y) * g0.z * bflo(gb.y), bfhi(v.y) * g0.w * bfhi(gb.y));
            w.z = pk2(bflo(v.z) * g1.x * bflo(gb.z), bfhi(v.z) * g1.y * bfhi(gb.z));
            w.w = pk2(bflo(v.w) * g1.z * bflo(gb.w), bfhi(v.w) * g1.w * bfhi(gb.w));
            *(u32x4*)(Y + token * 2048 + 1024 + col) = w;
        }
    }
    __syncthreads();
}

DI void p4_final_rows(const float* x, const bf16_t* dl, float* out, const float* g, int gw, int nw, int lane) {
    for (int row = gw; row < MTOK; row += nw) {
        const f32x4* xr = (const f32x4*)(x + (size_t)row * DM) + lane;
        const u32x2* dr = (const u32x2*)(dl + (size_t)row * DM) + lane;
        f32x4 v[8]; float s = 0.f;
#pragma unroll
        for (int j = 0; j < 8; ++j) { const f32x4 xv = __builtin_nontemporal_load(xr + 64 * j); const u32x2 d2 = __builtin_nontemporal_load(dr + 64 * j);
            v[j].x = xv.x + bflo(d2.x); v[j].y = xv.y + bfhi(d2.x); v[j].z = xv.z + bflo(d2.y); v[j].w = xv.w + bfhi(d2.y);
            s += (v[j].x * v[j].x + v[j].y * v[j].y) + (v[j].z * v[j].z + v[j].w * v[j].w); }
        s = wave_sum(s);
        const float rstd = __builtin_amdgcn_rsqf(s * (1.0f / DM) + EPS);
        f32x4* ow = (f32x4*)(out + (size_t)row * DM) + lane;
#pragma unroll
        for (int j = 0; j < 8; ++j) { const f32x4 gg = ((const f32x4*)g)[lane + 64 * j]; __builtin_nontemporal_store(v[j] * rstd * gg, ow + 64 * j); }
    }
}

__global__ __launch_bounds__(NTHREADS, 2) void hymba_mega(Params p) {
    extern __shared__ __attribute__((aligned(16))) char lds[];
    cg::grid_group grid = cg::this_grid();
    const int tid = threadIdx.x, lane = tid & 63, wid = __builtin_amdgcn_readfirstlane(tid >> 6);
    const int bid = blockIdx.x, G = gridDim.x;
    const int gw = bid * 8 + wid, nw = G * 8;

    {
#if PROBE_REP == 1
    p0_rmsnorm_rows(p.in[0], p.in[1], (bf16_t*)(p.ws + WS_H), gw, nw, lane);
#endif
    p0_rmsnorm_rows(p.in[0], p.in[1], (bf16_t*)(p.ws + WS_H), gw, nw, lane);
    {
        float* scr = (float*)lds + wid * (64 * 33);
        const int n1 = (DM / 64) * (DIN / 32), n2 = (DM / 64) * (DM / 32);
        for (int it = gw; it < n1 + n2; it += nw) {
            if (it < n1) p0_transpose_item(p.in[2], DM, DIN, (bf16_t*)(p.ws + WS_WIN), scr, it, lane);
            else p0_transpose_item(p.in[13], DM, DM, (bf16_t*)(p.ws + WS_WOUT), scr, it - n1, lane);
        }
    }
    }
    grid.sync();

    {
#if PROBE_REP == 2
        gemm_phase<0>((lds_ptr)lds, (const bf16_t*)(p.ws + WS_H), (const bf16_t*)(p.ws + WS_WIN), DM, MTOK / BM, DIN / BM, bid, G, p, wid);
#endif
        gemm_phase<0>((lds_ptr)lds, (const bf16_t*)(p.ws + WS_H), (const bf16_t*)(p.ws + WS_WIN), DM, MTOK / BM, DIN / BM, bid, G, p, wid);
    }
    grid.sync();

    {
        int tid2 = fresh_tid(wid);
        const int tid = tid2, lane = tid & 63;
        for (int rep_ = 0; rep_ < (PROBE_REP == 3 ? 2 : 1); ++rep_)
        for (int item = bid; item < 256; item += G) sgu_item(p, item, lds, tid, lane, wid);
        const int tidA = fresh_tid(wid), laneA = tidA & 63;
        float lam;
        { const float a = wave_sum(p.in[7][laneA] * p.in[8][laneA]), c = wave_sum(p.in[9][laneA] * p.in[10][laneA]); lam = __uint_as_float(__builtin_amdgcn_readfirstlane(__float_as_uint(__expf(a) - __expf(c) + 0.2f))); }
        for (int rep_ = 0; rep_ < (PROBE_REP == 4 ? 2 : 1); ++rep_)
        for (int it = bid; it < 1024; it += G) {
            const int xcd = it & 7, rest = it >> 3;
            const int bh = xcd * 2 + (rest >> 6), j = rest & 63;
            attn_unit(p, bh, 127 - j, lds, lam, tidA, laneA, wid, true);
            attn_unit(p, bh, j, lds, lam, tidA, laneA, wid, false);
        }
    }
    grid.sync();

    {
#if PROBE_REP == 5
        gemm_phase<1>((lds_ptr)lds, (const bf16_t*)(p.ws + WS_Y), (const bf16_t*)(p.ws + WS_WOUT), DM, MTOK / BM, DM / BM, bid, G, p, wid);
#endif
        gemm_phase<1>((lds_ptr)lds, (const bf16_t*)(p.ws + WS_Y), (const bf16_t*)(p.ws + WS_WOUT), DM, MTOK / BM, DM / BM, bid, G, p, wid);
    }
    grid.sync();

    {
        const int t4 = fresh_tid(wid);
        p4_final_rows(p.in[0], (const bf16_t*)(p.ws + WS_H), p.out, p.in[14], bid * 8 + wid, nw, t4 & 63);
    }
}

extern "C" void kernel_launch(void* const* d_in, const int* in_sizes, int n_in, void* d_out, int out_size, void* d_ws, size_t ws_size, hipStream_t stream) {
    static int grid_blocks = 0;
    if (grid_blocks == 0) {
        if (n_in != 15 || ws_size < WS_END) { fprintf(stderr, "kernel_launch: unexpected n_in %d / ws_size %zu\n", n_in, ws_size); grid_blocks = -1; return; }
        int dev = 0, cus = 0, per_cu = 0;
        hipGetDevice(&dev);
        hipDeviceGetAttribute(&cus, hipDeviceAttributeMultiprocessorCount, dev);
        if (hipFuncSetAttribute((const void*)hymba_mega, hipFuncAttributeMaxDynamicSharedMemorySize, LDS_BYTES) != hipSuccess) fprintf(stderr, "kernel_launch: hipFuncSetAttribute failed\n");
        if (hipOccupancyMaxActiveBlocksPerMultiprocessor(&per_cu, (const void*)hymba_mega, NTHREADS, LDS_BYTES) != hipSuccess || per_cu < 1) { fprintf(stderr, "kernel_launch: occupancy query gave %d\n", per_cu); per_cu = 1; }
        (void)hipGetLastError();
        grid_blocks = cus * 1;
    }
    if (grid_blocks < 0) return;
    Params p{};
    for (int i = 0; i < 15; ++i) p.in[i] = (const float*)d_in[i];
    p.out = (float*)d_out; p.ws = (char*)d_ws;
    void* args[] = {&p};
    hipError_t e = hipLaunchCooperativeKernel((const void*)hymba_mega, dim3(grid_blocks), dim3(NTHREADS), args, LDS_BYTES, stream);
    if (e != hipSuccess) fprintf(stderr, "cooperative launch failed: %s (grid %d)\n", hipGetErrorString(e), grid_blocks);
}
```

```cpp
#include <hip/hip_runtime.h>
#include <hip/hip_cooperative_groups.h>
#include <cstdio>
#include <cstdint>
namespace cg = cooperative_groups;

#define DI __device__ __forceinline__
typedef unsigned short bf16_t;
using bf16x8 = __attribute__((ext_vector_type(8))) short;
using s16x4  = __attribute__((ext_vector_type(4))) short;
using f32x4  = __attribute__((ext_vector_type(4))) float;
using f32x16 = __attribute__((ext_vector_type(16))) float;
using u32x4  = __attribute__((ext_vector_type(4))) unsigned;
using u32x2  = __attribute__((ext_vector_type(2))) unsigned;
typedef short v4i16_t __attribute__((ext_vector_type(4)));
typedef __attribute__((address_space(3))) const char* lds_cptr;

constexpr int MTOK = 32768, SEQ = 16384, DM = 2048, DIN = 7168;
constexpr float EPS = 1e-6f;
constexpr float LOG2E = 1.4426950408889634f;
constexpr int NTHREADS = 512;
constexpr int LDS_BYTES = 131072;
#ifndef PHASE_MASK
#define PHASE_MASK 31
#endif
#ifndef PROBE_REP
#define PROBE_REP 0
#endif
#ifndef ATT_STAGGER
#define ATT_STAGGER 0
#endif

constexpr size_t SZ_H = (size_t)MTOK * DM * 2;
constexpr size_t SZ_WIN = (size_t)DIN * DM * 2;
constexpr size_t SZ_WOUT = (size_t)DM * DM * 2;
constexpr size_t SZ_SEG = (size_t)MTOK * 1024 * 2;
constexpr size_t WS_H = 0;
constexpr size_t WS_WIN = WS_H + SZ_H;
constexpr size_t WS_WOUT = WS_WIN + SZ_WIN;
constexpr size_t WS_U = WS_WOUT + SZ_WOUT;
constexpr size_t WS_GV = WS_U + SZ_SEG;
constexpr size_t WS_SGA = WS_GV + SZ_SEG;
constexpr size_t WS_SGB = WS_SGA + SZ_SEG;
constexpr size_t WS_Q = WS_SGB + SZ_SEG;
constexpr size_t WS_K = WS_Q + SZ_SEG;
constexpr size_t WS_V = WS_K + SZ_SEG;
constexpr size_t WS_Y = WS_V + SZ_SEG;
constexpr size_t WS_END = WS_Y + SZ_H;

struct Params {
    const float* in[15];
    float* out;
    char* ws;
};

typedef __bf16 bf16x2_t __attribute__((ext_vector_type(2)));
typedef float f32x2_t __attribute__((ext_vector_type(2)));
DI unsigned pk2(float lo, float hi) { f32x2_t v = {lo, hi}; bf16x2_t b = __builtin_convertvector(v, bf16x2_t); return __builtin_bit_cast(unsigned, b); }
DI float bflo(unsigned u) { return __uint_as_float(u << 16); }
DI float bfhi(unsigned u) { return __uint_as_float(u & 0xffff0000u); }
DI float wave_sum(float v) {
#pragma unroll
    for (int o = 1; o < 64; o <<= 1) v += __shfl_xor(v, o);
    return v;
}
DI float ex2(float x) { return __builtin_amdgcn_exp2f(x); }
DI int fresh_tid(int wid) { int z = 0; asm volatile("" : "+v"(z)); return wid * 64 + (int)__builtin_amdgcn_mbcnt_hi(~0u, __builtin_amdgcn_mbcnt_lo(~0u, (unsigned)z)); }
DI float gelu_f(float x) {
    const float c1 = 2.0f * 0.7978845608028654f * LOG2E, c2 = c1 * 0.044715f;
    const float z = x * (c1 + c2 * x * x);
    return x * __builtin_amdgcn_rcpf(1.0f + ex2(-z));
}
DI float silu_f(float x) { return x * __builtin_amdgcn_rcpf(1.0f + ex2(-x * LOG2E)); }
DI float swap_max(float m) { auto rr = __builtin_amdgcn_permlane32_swap(__float_as_uint(m), __float_as_uint(m), false, false); return __builtin_fmaxf(__uint_as_float(rr[0]), __uint_as_float(rr[1])); }
DI float swap_sum(float m) { auto rr = __builtin_amdgcn_permlane32_swap(__float_as_uint(m), __float_as_uint(m), false, false); return __uint_as_float(rr[0]) + __uint_as_float(rr[1]); }
DI s16x4 vtr(lds_cptr p) { return __builtin_bit_cast(s16x4, __builtin_amdgcn_ds_read_tr16_b64_v4i16((__attribute__((address_space(3))) v4i16_t*)p)); }
#define MFMA32(a, b, c) __builtin_amdgcn_mfma_f32_32x32x16_bf16((a), (b), (c), 0, 0, 0)
#define MFMA16(a, b, c) __builtin_amdgcn_mfma_f32_16x16x32_bf16((a), (b), (c), 0, 0, 0)

DI void p0_rmsnorm_rows(const float* x, const float* g, bf16_t* h, int gw, int nw, int lane) {
    for (int row = gw; row < MTOK; row += nw) {
        const f32x4* xr = (const f32x4*)(x + (size_t)row * DM) + lane;
        f32x4 v[8]; float s = 0.f;
#pragma unroll
        for (int j = 0; j < 8; ++j) { v[j] = __builtin_nontemporal_load(xr + 64 * j); s += (v[j].x * v[j].x + v[j].y * v[j].y) + (v[j].z * v[j].z + v[j].w * v[j].w); }
        s = wave_sum(s);
        const float rstd = __builtin_amdgcn_rsqf(s * (1.0f / DM) + EPS);
        u32x2* o8 = (u32x2*)(h + (size_t)row * DM) + lane;
#pragma unroll
        for (int j = 0; j < 8; ++j) {
            const f32x4 gg = ((const f32x4*)g)[lane + 64 * j];
            u32x2 o; o.x = pk2(v[j].x * rstd * gg.x, v[j].y * rstd * gg.y); o.y = pk2(v[j].z * rstd * gg.z, v[j].w * rstd * gg.w);
            o8[64 * j] = o;
        }
    }
}
DI void p0_transpose_item(const float* W, int K, int N, bf16_t* WT, float* scr, int item, int lane) {
    const int nblk = N / 32, kb = item / nblk, nb = item % nblk, k0 = 64 * kb, n0 = 32 * nb;
#pragma unroll 8
    for (int i = 0; i < 32; ++i) { const int kk = 2 * i + (lane >> 5); scr[kk * 33 + (lane & 31)] = __builtin_nontemporal_load(W + (size_t)(k0 + kk) * N + n0 + (lane & 31)); }
    asm volatile("s_waitcnt vmcnt(0) lgkmcnt(0)" ::: "memory");
    const int c = lane & 7;
#pragma unroll
    for (int j = 0; j < 4; ++j) {
        const int n = (lane >> 3) + 8 * j; const float* s = scr + (8 * c) * 33 + n;
        u32x4 o; o.x = pk2(s[0], s[33]); o.y = pk2(s[66], s[99]); o.z = pk2(s[132], s[165]); o.w = pk2(s[198], s[231]);
        *(u32x4*)(WT + (size_t)(n0 + n) * K + k0 + 8 * c) = o;
    }
    asm volatile("s_waitcnt lgkmcnt(0)" ::: "memory");
}

constexpr int BM = 256, BK = 64, HALF = 128, HT = HALF * BK;
DI int lds_byte(int r, int c) { int st = (r >> 4) * 2 + (c >> 5), rr = r & 15, cc = c & 31, ob = rr * 64 + cc * 2; return st * 1024 + (ob ^ (((ob >> 9) & 1) << 5)); }
DI void stage_rc(int b, int& R, int& C) { int st = b / 1024, sb = b % 1024, swz = sb ^ (((sb >> 9) & 1) << 5); R = (st >> 1) * 16 + swz / 64; C = (st & 1) * 32 + (swz % 64) / 2; }

DI void tile_order(int L, int nM, int nN, int& pm, int& pn) {
    const int nwg = nM * nN; int wgid = L;
    { const int q = nwg / 8, r = nwg % 8, xcd = wgid % 8, off = wgid / 8; wgid = (xcd < r ? xcd * (q + 1) : r * (q + 1) + (xcd - r) * q) + off; }
    const int nig = 8 * nN, gid = wgid / nig, fm = gid * 8, gsz = (nM - fm) < 8 ? (nM - fm) : 8;
    pm = fm + ((wgid % nig) % gsz); pn = (wgid % nig) / gsz;
}

typedef __attribute__((address_space(3))) unsigned char* lds_ptr;
template <int EPI>
DI void gemm_epilogue(const f32x4 (&acc)[2][2][4][2], const int brow, const int bcol, const int wr, const int wc, const int fr, const int fq, const Params& p) {
    if (EPI == 0) {
        const int seg = bcol >> 10;
        bf16_t* segbase = (bf16_t*)(p.ws + (seg == 0 ? WS_U : seg == 1 ? WS_GV : seg == 2 ? WS_SGA : seg == 3 ? WS_Q : seg == 4 ? WS_K : seg == 5 ? WS_V : WS_SGB));
        const int c8 = (fq & 1) ? 16 + 4 * (fq - 1) : 4 * fq;
#pragma unroll 1
        for (int ai = 0; ai < 2; ++ai)
#pragma unroll
        for (int m = 0; m < 4; ++m) {
            const int row = brow + ai * HALF + wr * 64 + m * 16 + fr;
            const int bb = row >> 14, s = row & (SEQ - 1);
#pragma unroll
            for (int bj = 0; bj < 2; ++bj) {
                u32x2 og[2];
#pragma unroll
                for (int n = 0; n < 2; ++n) {
                    f32x4 v = ai == 0 ? acc[0][bj][m][n] : acc[1][bj][m][n];
                    if (seg <= 1) { v.x = gelu_f(v.x); v.y = gelu_f(v.y); v.z = gelu_f(v.z); v.w = gelu_f(v.w); }
                    else if (seg == 2 || seg == 6) { v.x = silu_f(v.x); v.y = silu_f(v.y); v.z = silu_f(v.z); v.w = silu_f(v.w); }
                    else if (seg == 3) { const float sc = 0.125f * LOG2E; v.x *= sc; v.y *= sc; v.z *= sc; v.w *= sc; }
                    og[n].x = pk2(v.x, v.y); og[n].y = pk2(v.z, v.w);
                }
                const auto rx = __builtin_amdgcn_permlane16_swap(og[0].x, og[1].x, false, false);
                const auto ry = __builtin_amdgcn_permlane16_swap(og[0].y, og[1].y, false, false);
                u32x4 o; o.x = rx[0]; o.y = ry[0]; o.z = rx[1]; o.w = ry[1];
                const int col = (bcol & 1023) + bj * HALF + wc * 32 + c8;
                size_t idx;
                if (seg <= 2 || seg == 6) idx = (size_t)row * 1024 + col;
                else if (seg == 3) { const int hh = col >> 7, mp = (col >> 6) & 1, d = col & 63; idx = ((size_t)((bb * 8 + hh) * 2 + mp) * SEQ + s) * 64 + d; }
                else if (seg == 4) { const int hh = col >> 7, mp = (col >> 6) & 1, d = col & 63;
                    idx = ((((size_t)(bb * 8 + hh) * 256 + (s >> 6)) * 2 + mp) * 8 + (d >> 3)) * 512 + (size_t)(s & 63) * 8; }
                else { const int hh = col >> 7, dv = col & 127;
                    idx = (((size_t)(bb * 8 + hh) * 256 + (s >> 6)) * 4 + (dv >> 5)) * 2048 + (size_t)(s & 63) * 32 + (dv & 31); }
                *(u32x4*)(segbase + idx) = o;
            }
        }
    } else {
        bf16_t* dl = (bf16_t*)(p.ws + WS_H);
        const int c8 = (fq & 1) ? 16 + 4 * (fq - 1) : 4 * fq;
#pragma unroll
        for (int ai = 0; ai < 2; ++ai)
#pragma unroll
        for (int m = 0; m < 4; ++m) {
            const int row = brow + ai * HALF + wr * 64 + m * 16 + fr;
#pragma unroll
            for (int bj = 0; bj < 2; ++bj) {
                u32x2 og[2];
#pragma unroll
                for (int n = 0; n < 2; ++n) { const f32x4 v = acc[ai][bj][m][n]; og[n].x = pk2(v.x, v.y); og[n].y = pk2(v.z, v.w); }
                const auto rx = __builtin_amdgcn_permlane16_swap(og[0].x, og[1].x, false, false);
                const auto ry = __builtin_amdgcn_permlane16_swap(og[0].y, og[1].y, false, false);
                u32x4 o; o.x = rx[0]; o.y = ry[0]; o.z = rx[1]; o.w = ry[1];
                const int col = bcol + bj * HALF + wc * 32 + c8;
                *(u32x4*)(dl + (size_t)row * DM + col) = o;
            }
        }
    }
}

template <int EPI>
DI void gemm_phase(lds_ptr lds, const bf16_t* __restrict__ Ag, const bf16_t* __restrict__ Btg, const int K, const int nM, const int nN, const int bid, const int G, const Params& p, const int wid0) {
    int tid_l = fresh_tid(wid0);
    const int tid = tid_l, wid = __builtin_amdgcn_readfirstlane(tid >> 6), lane = tid & 63, wr = wid >> 2, wc = wid & 3, fr = lane & 15, fq = lane >> 4;
    const int nt = K / BK, nunits = nM * nN;
    constexpr int HTB = HALF * BK * 2;
    unsigned voff[2];
#pragma unroll
    for (int i = 0; i < 2; ++i) { int R, C; stage_rc(tid * 16 + i * 8192, R, C); voff[i] = (unsigned)(R * K + C) * 2u; }
    const size_t kstep = (size_t)(BK * 2), hstep = (size_t)HALF * K * 2, tstep = 2 * hstep;
    const unsigned ldsw = (unsigned)wid * 1024u;
    const int aoff = lds_byte(wr * 64 + fr, fq * 8), boff = lds_byte(wc * 32 + fr, fq * 8);
#define SAo(b, h) (((b) * 2 + (h)) * HTB)
#define SBo(b, h) ((4 + (b) * 2 + (h)) * HTB)
#define STAGE(bufoff, gbase) do { _Pragma("unroll") for (int _i = 0; _i < 2; ++_i) \
        __builtin_amdgcn_global_load_lds((const __attribute__((address_space(1))) unsigned*)((const char*)(gbase) + voff[_i]), (__attribute__((address_space(3))) unsigned*)(lds + (bufoff) + ldsw + _i * 8192), 16, 0, 0); } while (0)
#define LDA(dst, b, h) do { _Pragma("unroll") for (int m = 0; m < 4; ++m) _Pragma("unroll") for (int k = 0; k < 2; ++k) dst[m][k] = *(const __attribute__((address_space(3))) bf16x8*)(lds + SAo(b, h) + aoff + m * 2048 + k * 1024); } while (0)
#define LDB(dst, b, h) do { _Pragma("unroll") for (int n = 0; n < 2; ++n) _Pragma("unroll") for (int k = 0; k < 2; ++k) dst[n][k] = *(const __attribute__((address_space(3))) bf16x8*)(lds + SBo(b, h) + boff + n * 2048 + k * 1024); } while (0)
#define MMA(ai, bj, At_, Bt_) do { __builtin_amdgcn_s_setprio(1); _Pragma("unroll") for (int m = 0; m < 4; ++m) _Pragma("unroll") for (int n = 0; n < 2; ++n) _Pragma("unroll") for (int k = 0; k < 2; ++k) \
        acc[ai][bj][m][n] = MFMA16(Bt_[n][k], At_[m][k], acc[ai][bj][m][n]); __builtin_amdgcn_s_setprio(0); } while (0)
#define WAIT_V(n) asm volatile("s_waitcnt vmcnt(" #n ")" ::: "memory")
#define WAIT_L(n) asm volatile("s_waitcnt lgkmcnt(" #n ")" ::: "memory")
#define BAR __builtin_amdgcn_s_barrier()
#define SCHED __builtin_amdgcn_sched_barrier(0)
    if (bid >= nunits) return;
    int ui = 0, cpm, cpn, npm = 0, npn = 0;
    tile_order(bid, nM, nN, cpm, cpn);
    f32x4 acc[2][2][4][2];
#pragma unroll
    for (int a = 0; a < 2; ++a)
#pragma unroll
        for (int b = 0; b < 2; ++b)
#pragma unroll
            for (int m = 0; m < 4; ++m)
#pragma unroll
                for (int n = 0; n < 2; ++n) acc[a][b][m][n] = (f32x4){0.f, 0.f, 0.f, 0.f};
    bf16x8 At[4][2], B0[2][2], B1[2][2];
    const char* cA = (const char*)Ag + (size_t)cpm * tstep; const char* cB = (const char*)Btg + (size_t)cpn * tstep;
    STAGE(SBo(0, 0), cB); STAGE(SAo(0, 0), cA); STAGE(SBo(0, 1), cB + hstep); STAGE(SAo(0, 1), cA + hstep);
    if (wr == 1) BAR;
    WAIT_V(4); BAR;
    STAGE(SBo(1, 0), cB + kstep); STAGE(SAo(1, 0), cA + kstep); STAGE(SBo(1, 1), cB + hstep + kstep);
    WAIT_V(6); BAR;
    for (;;) {
        const bool has_next = (ui + 1) * G + bid < nunits;
        if (has_next) tile_order((ui + 1) * G + bid, nM, nN, npm, npn);
        const char* nA = has_next ? (const char*)Ag + (size_t)npm * tstep : cA; const char* nB = has_next ? (const char*)Btg + (size_t)npn * tstep : cB;
        for (int t = 0; t < nt; t += 2) {
            const bool last = (t == nt - 2);
            const char* a1 = cA + (size_t)(t + 1) * kstep;
            const char* a2 = last ? nA : cA + (size_t)(t + 2) * kstep; const char* b2 = last ? nB : cB + (size_t)(t + 2) * kstep;
            const char* a3 = a2 + kstep; const char* b3 = b2 + kstep;
            LDB(B0, 0, 0); SCHED; LDA(At, 0, 0); STAGE(SAo(1, 1), a1 + hstep);
            WAIT_L(8); BAR; WAIT_L(0); MMA(0, 0, At, B0); BAR; SCHED;
            LDB(B1, 0, 1); STAGE(SBo(0, 0), b2);
            BAR; WAIT_L(0); MMA(0, 1, At, B1); BAR;
            LDA(At, 0, 1); STAGE(SAo(0, 0), a2);
            BAR; WAIT_L(0); MMA(1, 0, At, B0); BAR; SCHED;
            STAGE(SBo(0, 1), b2 + hstep);
            WAIT_V(6); BAR; MMA(1, 1, At, B1); BAR;
            LDB(B0, 1, 0); SCHED; LDA(At, 1, 0); STAGE(SAo(0, 1), a2 + hstep);
            WAIT_L(8); BAR; WAIT_L(0); MMA(0, 0, At, B0); BAR; SCHED;
            LDB(B1, 1, 1); STAGE(SBo(1, 0), b3);
            BAR; WAIT_L(0); MMA(0, 1, At, B1); BAR;
            LDA(At, 1, 1); STAGE(SAo(1, 0), a3);
            BAR; WAIT_L(0); MMA(1, 0, At, B0); BAR; SCHED;
            STAGE(SBo(1, 1), b3 + hstep);
            WAIT_V(6); BAR; MMA(1, 1, At, B1); BAR;
        }
        gemm_epilogue<EPI>(acc, cpm * BM, cpn * BM, wr, wc, fr, fq, p);
        if (!has_next) break;
#pragma unroll
        for (int a = 0; a < 2; ++a)
#pragma unroll
            for (int b = 0; b < 2; ++b)
#pragma unroll
                for (int m = 0; m < 4; ++m)
#pragma unroll
                    for (int n = 0; n < 2; ++n) acc[a][b][m][n] = (f32x4){0.f, 0.f, 0.f, 0.f};
        cpm = npm; cpn = npn; cA = nA; cB = nB; ++ui;
    }
    WAIT_V(0);
    if (wr == 0) BAR;
    BAR;
#undef SAo
#undef SBo
#undef STAGE
#undef LDA
#undef LDB
#undef MMA
}

DI void sgu_item(const Params& p, int item, char* lds, int tid, int lane, int wid) {
    const int r0 = item * 128, r32 = lane & 31, hi = lane >> 5;
    const bf16_t* GV = (const bf16_t*)(p.ws + WS_GV); const bf16_t* U = (const bf16_t*)(p.ws + WS_U); const bf16_t* SGA = (const bf16_t*)(p.ws + WS_SGA);
    bf16_t* Y = (bf16_t*)(p.ws + WS_Y);
    float* stats = (float*)(lds + 98304);
#pragma unroll 1
    for (int rb = 0; rb < 16; rb += 8) {
        u32x4 a[8], b2[8];
#pragma unroll
        for (int rr = 0; rr < 8; ++rr) { const u32x4* src = (const u32x4*)(GV + (size_t)(r0 + 16 * wid + rb + rr) * 1024); a[rr] = src[lane]; b2[rr] = src[lane + 64]; }
#pragma unroll
        for (int rr = 0; rr < 8; ++rr) {
            float s = 0.f, ss = 0.f;
#pragma unroll
            for (int e = 0; e < 4; ++e) { float f0 = bflo(a[rr][e]), f1 = bfhi(a[rr][e]), f2 = bflo(b2[rr][e]), f3 = bfhi(b2[rr][e]); s += (f0 + f1) + (f2 + f3); ss += (f0 * f0 + f1 * f1) + (f2 * f2 + f3 * f3); }
            s = wave_sum(s); ss = wave_sum(ss);
            if (lane == 0) { const float mean = s * (1.f / 1024.f); const float var = ss * (1.f / 1024.f) - mean * mean; stats[(16 * wid + rb + rr) * 2] = mean; stats[(16 * wid + rb + rr) * 2 + 1] = __builtin_amdgcn_rsqf(var + EPS); }
        }
    }
    __syncthreads();
    const float* lng = p.in[3]; const float* lnb = p.in[4]; const float* sw = p.in[5]; const float* sb = p.in[6];
    const int tb = wid & 3, ch = wid >> 2, t = tb * 32 + r32;
    for (int g = 0; g < 8; ++g) {
#pragma unroll
        for (int i = 0; i < 4; ++i) {
            const int q = tid + 512 * i, s = q >> 4, cc = q & 15;
            const u32x4 raw = *(const u32x4*)(GV + (size_t)(r0 + s) * 1024 + g * 128 + cc * 8);
            const float mean = stats[2 * s], rstd = stats[2 * s + 1];
            const f32x4 g0 = *(const f32x4*)(lng + g * 128 + cc * 8), g1 = *(const f32x4*)(lng + g * 128 + cc * 8 + 4);
            const f32x4 b0 = *(const f32x4*)(lnb + g * 128 + cc * 8), b1 = *(const f32x4*)(lnb + g * 128 + cc * 8 + 4);
            u32x4 o;
            o.x = pk2((bflo(raw.x) - mean) * rstd * g0.x + b0.x, (bfhi(raw.x) - mean) * rstd * g0.y + b0.y);
            o.y = pk2((bflo(raw.y) - mean) * rstd * g0.z + b0.z, (bfhi(raw.y) - mean) * rstd * g0.w + b0.w);
            o.z = pk2((bflo(raw.z) - mean) * rstd * g1.x + b1.x, (bfhi(raw.z) - mean) * rstd * g1.y + b1.y);
            o.w = pk2((bflo(raw.w) - mean) * rstd * g1.z + b1.z, (bfhi(raw.w) - mean) * rstd * g1.w + b1.w);
            *(u32x4*)(lds + (cc >> 2) * 8192 + s * 64 + (cc & 3) * 16) = o;
        }
        __syncthreads();
        f32x16 d[2]; d[0] = f32x16{}; d[1] = f32x16{};
        const float* wrow = sw + ((size_t)g * 128 + t) * 128;
        const lds_cptr vp = (lds_cptr)lds + ((lane >> 4) & 1) * 32 + (lane & 3) * 8 + ((lane & 15) >> 2) * 64;
#pragma unroll
        for (int ks = 0; ks < 8; ++ks) {
            const int s0 = 16 * ks + 8 * hi;
            f32x4 w0 = *(const f32x4*)(wrow + s0), w1 = *(const f32x4*)(wrow + s0 + 4);
            if ((s0 >> 6) > (t >> 6)) { w0 = f32x4{0.f, 0.f, 0.f, 0.f}; w1 = w0; }
            u32x4 wp; wp.x = pk2(w0.x, w0.y); wp.y = pk2(w0.z, w0.w); wp.z = pk2(w1.x, w1.y); wp.w = pk2(w1.z, w1.w);
            const bf16x8 wf = __builtin_bit_cast(bf16x8, wp);
#pragma unroll
            for (int cbi = 0; cbi < 2; ++cbi) {
                const int cb = 2 * ch + cbi;
                const s16x4 lo = vtr(vp + cb * 8192 + s0 * 64), hi4 = vtr(vp + cb * 8192 + (s0 + 4) * 64);
                const bf16x8 vf = __builtin_shufflevector(lo, hi4, 0, 1, 2, 3, 4, 5, 6, 7);
                d[cbi] = MFMA32(vf, wf, d[cbi]);
            }
            if (ks & 1) __builtin_amdgcn_sched_barrier(0);
        }
        const float bs = sb[g * 128 + t];
        char* stg = lds + 32768;
#pragma unroll
        for (int cbi = 0; cbi < 2; ++cbi)
#pragma unroll
        for (int ig = 0; ig < 4; ++ig) {
            const int cl = (2 * ch + cbi) * 32 + 8 * ig + 4 * hi;
            u32x2 o; o.x = pk2(d[cbi][4 * ig] + bs, d[cbi][4 * ig + 1] + bs); o.y = pk2(d[cbi][4 * ig + 2] + bs, d[cbi][4 * ig + 3] + bs);
            *(u32x2*)(stg + t * 272 + cl * 2) = o;
        }
        __syncthreads();
#pragma unroll
        for (int i = 0; i < 4; ++i) {
            const int q = tid + 512 * i, r = q >> 4, cc = q & 15;
            const u32x4 mx = *(const u32x4*)(stg + r * 272 + cc * 16);
            const size_t rw = (size_t)(r0 + r); const int c = g * 128 + cc * 8;
            const u32x4 uu = __builtin_nontemporal_load((const u32x4*)(U + rw * 1024 + c)), gg = __builtin_nontemporal_load((const u32x4*)(SGA + rw * 1024 + c));
            u32x4 o;
            o.x = pk2(bflo(uu.x) * bflo(mx.x) * bflo(gg.x), bfhi(uu.x) * bfhi(mx.x) * bfhi(gg.x));
            o.y = pk2(bflo(uu.y) * bflo(mx.y) * bflo(gg.y), bfhi(uu.y) * bfhi(mx.y) * bfhi(gg.y));
            o.z = pk2(bflo(uu.z) * bflo(mx.z) * bflo(gg.z), bfhi(uu.z) * bfhi(mx.z) * bfhi(gg.z));
            o.w = pk2(bflo(uu.w) * bflo(mx.w) * bflo(gg.w), bfhi(uu.w) * bfhi(mx.w) * bfhi(gg.w));
            *(u32x4*)(Y + rw * 2048 + c) = o;
        }
    }
    __syncthreads();
}

DI int t5_bucket_dev(int rel) {
    const int side = rel > 0 ? 16 : 0; const int n = rel < 0 ? -rel : rel;
    int v;
    if (n < 8) v = n; else if (n < 12) v = 8; else if (n < 16) v = 9; else if (n < 23) v = 10; else if (n < 32) v = 11; else if (n < 46) v = 12; else if (n < 64) v = 13; else if (n < 91) v = 14; else v = 15;
    return side + v;
}

DI void attn_unit(const Params& p, int bh, int qb, char* lds, float lam, int tid, int lane, int wid, const bool build_tab) {
    const int h = bh & 7, b = bh >> 3;
    const int map = wid & 1, qblk = wid >> 1, r32 = lane & 31, hi = lane >> 5;
    const int NT = 2 * qb + 2, ntw = 2 * qb + 1 + (qblk >> 1);
    float* tab = (float*)(lds + 98304);
    const char* KGc = p.ws + WS_K + ((size_t)bh * 256 << 14) + tid * 16;
    const char* VGc = p.ws + WS_V + ((size_t)bh * 256 << 14) + tid * 16;
#define GLDS16(gp_, ldsoff_) do { unsigned sv_; asm volatile("s_mov_b32 %0, m0\n\ts_mov_b32 m0, %2\n\ts_nop 0\n\tglobal_load_lds_dwordx4 %1, off\n\ts_mov_b32 m0, %0" : "=&s"(sv_) : "v"(gp_), "s"(ldsoff_) : "memory"); } while (0)
#define GLOAD(t_, slotoff_) do { const char* kb_ = KGc + ((size_t)(t_) << 14); const char* vb_ = VGc + ((size_t)(t_) << 14); \
        const unsigned d_ = (unsigned)__builtin_amdgcn_readfirstlane((int)(ldsbase + (slotoff_) + wid * 1024)); \
        GLDS16(kb_, d_); GLDS16(kb_ + 8192, d_ + 8192u); GLDS16(vb_, d_ + 16384u); GLDS16(vb_ + 8192, d_ + 24576u); } while (0)
    const unsigned ldsbase = (unsigned)(uintptr_t)(__attribute__((address_space(3))) char*)lds;
#define SCHEDB() __builtin_amdgcn_sched_barrier(0)
    const int qrow0 = 128 * qb + 32 * qblk;
    bf16x8 qf[4];
    { const bf16_t* qrow = (const bf16_t*)(p.ws + WS_Q) + ((size_t)(bh * 2 + map) * SEQ + qrow0 + r32) * 64 + hi * 8;
#pragma unroll
      for (int d0 = 0; d0 < 4; ++d0) qf[d0] = *(const bf16x8*)(qrow + 16 * d0); }
    GLOAD(0, 0);
    GLOAD(1, 32768);
    if (build_tab && tid < 320) { const float* rb = p.in[12]; const int rel = tid - 256; tab[tid] = rel < -128 ? 0.f : (rb[t5_bucket_dev(rel) * 8 + h] - rb[15 * 8 + h]) * LOG2E; }
    asm volatile("s_waitcnt vmcnt(0)" ::: "memory");
    __syncthreads();
    const bool grpB = wid >= 4;
    if (ATT_STAGGER && grpB) __builtin_amdgcn_s_barrier();
    f32x16 o[4]; o[0] = f32x16{}; o[1] = f32x16{}; o[2] = f32x16{}; o[3] = f32x16{};
    float l = 0.f, nm = 0.f;
    f32x16 cinit = f32x16{};
    int sc = 0, sn1 = 32768, sn2 = 65536;
#define LOADV(dst, ks_) do { _Pragma("unroll") for (int dvb = 0; dvb < 4; ++dvb) { dst[2 * dvb] = vtr(vp + dvb * 4096 + (ks_) * 1024); dst[2 * dvb + 1] = vtr(vp + dvb * 4096 + (ks_) * 1024 + 512); } } while (0)
#define MF4(src, pfrag) do { _Pragma("unroll") for (int dvb = 0; dvb < 4; ++dvb) { \
        const bf16x8 vf_ = __builtin_shufflevector(src[2 * dvb], src[2 * dvb + 1], 0, 1, 2, 3, 4, 5, 6, 7); o[dvb] = MFMA32(vf_, pfrag, o[dvb]); } } while (0)
#define MX3(a_, b_, c_) __builtin_fmaxf(__builtin_fmaxf((a_), (b_)), (c_))
    for (int t = 0; t < NT; ++t) {
        const bool act = t < ntw;
        const lds_cptr vp = (lds_cptr)lds + sc + 16384 + ((lane >> 4) & 1) * 32 + (lane & 3) * 8 + (4 * hi + ((lane & 15) >> 2)) * 64;
        bf16x8 pf[4]; s16x4 va[8], vb[8];
        if (act) {
            const lds_cptr kp = (lds_cptr)lds + sc + map * 8192 + hi * 1024 + r32 * 16;
            bf16x8 kf[8];
#pragma unroll
            for (int d0 = 0; d0 < 4; ++d0) {
                kf[2 * d0] = *(const __attribute__((address_space(3))) bf16x8*)(kp + d0 * 2048);
                kf[2 * d0 + 1] = *(const __attribute__((address_space(3))) bf16x8*)(kp + d0 * 2048 + 512);
            }
            f32x16 s0 = cinit, s1 = cinit;
#pragma unroll
            for (int d0 = 0; d0 < 4; ++d0) { s0 = MFMA32(kf[2 * d0], qf[d0], s0); s1 = MFMA32(kf[2 * d0 + 1], qf[d0], s1); }
            LOADV(va, 0);
            if (t >= 2 * qb - 2) {
                const float* tb = tab + (64 * t - (qrow0 + r32) + 256 + 4 * hi);
#pragma unroll
                for (int i = 0; i < 16; ++i) {
                    s0[i] += tb[(i & 3) + 8 * (i >> 2)];
                    s1[i] += tb[(i & 3) + 8 * (i >> 2) + 32];
                }
            }
            float mxa = MX3(s0[0], s0[1], s1[0]), mxb = MX3(s0[2], s0[3], s1[1]); mxa = MX3(mxa, s1[2], s1[3]);
#pragma unroll
            for (int r = 4; r < 16; r += 4) { mxa = MX3(mxa, s0[r], s0[r + 1]); mxb = MX3(mxb, s0[r + 2], s0[r + 3]); mxa = MX3(mxa, s1[r], s1[r + 1]); mxb = MX3(mxb, s1[r + 2], s1[r + 3]); }
            float mx = swap_max(__builtin_fmaxf(mxa, mxb));
            const bool first = (t == 0);
            if (first || __builtin_amdgcn_ballot_w64(mx > 8.0f) != 0ull) {
                const float dl = first ? mx : __builtin_fmaxf(mx, 0.f);
                const float f = first ? 1.0f : ex2(-dl);
                l *= f; nm -= dl;
#pragma unroll
                for (int i = 0; i < 16; ++i) { o[0][i] *= f; o[1][i] *= f; o[2][i] *= f; o[3][i] *= f; cinit[i] = nm; s0[i] -= dl; s1[i] -= dl; }
            }
            asm volatile("s_waitcnt vmcnt(0)" ::: "memory");
            if (t + 2 < NT) GLOAD(t + 2, sn2);
            float rs0 = 0.f, rs1 = 0.f;
#define EXPQ(S, lo_, RS, PF) do { _Pragma("unroll") for (int i = lo_; i < lo_ + 8; ++i) { S[i] = ex2(S[i]); RS += S[i]; } \
              u32x4 w_; w_.x = pk2(S[lo_], S[lo_ + 1]); w_.y = pk2(S[lo_ + 2], S[lo_ + 3]); w_.z = pk2(S[lo_ + 4], S[lo_ + 5]); w_.w = pk2(S[lo_ + 6], S[lo_ + 7]); PF = __builtin_bit_cast(bf16x8, w_); } while (0)
            EXPQ(s0, 0, rs0, pf[0]);
            LOADV(vb, 1);
            MF4(va, pf[0]);
            EXPQ(s0, 8, rs1, pf[1]);
            LOADV(va, 2);
            MF4(vb, pf[1]);
            EXPQ(s1, 0, rs0, pf[2]);
            LOADV(vb, 3);
            MF4(va, pf[2]);
            EXPQ(s1, 8, rs1, pf[3]);
            MF4(vb, pf[3]);
            l += rs0 + rs1;
#undef EXPQ
        } else {
            asm volatile("s_waitcnt vmcnt(0)" ::: "memory");
            if (t + 2 < NT) GLOAD(t + 2, sn2);
        }
        SCHEDB();
        __builtin_amdgcn_s_barrier();
        SCHEDB();
        { const int tmp = sc; sc = sn1; sn1 = sn2; sn2 = tmp; }
    }
#undef LOADV
#undef MF4
#undef MX3
    if (ATT_STAGGER && !grpB) __builtin_amdgcn_s_barrier();
    asm volatile("s_waitcnt vmcnt(0) lgkmcnt(0)" ::: "memory");
    __syncthreads();
#undef GLOAD
#undef SCHEDB
    const float lt = swap_sum(l);
    const float inv = __builtin_amdgcn_rcpf(lt);
    float* xch = (float*)lds + qblk * 4096;
    if (map == 1) {
        const float sc = inv * lam;
#pragma unroll
        for (int dvb = 0; dvb < 4; ++dvb)
#pragma unroll
        for (int i = 0; i < 16; ++i) xch[(dvb * 16 + i) * 64 + lane] = o[dvb][i] * sc;
    }
    __syncthreads();
    if (map == 0) {
        float ss = 0.f;
#pragma unroll
        for (int dvb = 0; dvb < 4; ++dvb)
#pragma unroll
        for (int i = 0; i < 16; ++i) { const float v = o[dvb][i] * inv - xch[(dvb * 16 + i) * 64 + lane]; o[dvb][i] = v; ss += v * v; }
        ss = swap_sum(ss);
        const float r = __builtin_amdgcn_rsqf(ss * (1.f / 128.f) + EPS) * 0.8f;
        asm volatile("s_waitcnt lgkmcnt(0)" ::: "memory");
        char* stg = (char*)xch;
#pragma unroll
        for (int dvb = 0; dvb < 4; ++dvb)
#pragma unroll
        for (int ig = 0; ig < 4; ++ig) {
            const int dv = 32 * dvb + 8 * ig + 4 * hi;
            u32x2 w; w.x = pk2(o[dvb][4 * ig] * r, o[dvb][4 * ig + 1] * r); w.y = pk2(o[dvb][4 * ig + 2] * r, o[dvb][4 * ig + 3] * r);
            *(u32x2*)(stg + r32 * 272 + dv * 2) = w;
        }
        asm volatile("s_waitcnt lgkmcnt(0)" ::: "memory");
        const float* sg = p.in[11];
        const bf16_t* SGB = (const bf16_t*)(p.ws + WS_SGB); bf16_t* Y = (bf16_t*)(p.ws + WS_Y);
#pragma unroll
        for (int k = 0; k < 8; ++k) {
            const int id = lane + 64 * k, q = id >> 4, c = id & 15;
            const u32x4 v = *(const u32x4*)(stg + q * 272 + c * 16);
            const size_t token = (size_t)b * SEQ + qrow0 + q; const int col = h * 128 + c * 8;
            const u32x4 gb = __builtin_nontemporal_load((const u32x4*)(SGB + token * 1024 + col));
            const f32x4 g0 = *(const f32x4*)(sg + c * 8), g1 = *(const f32x4*)(sg + c * 8 + 4);
            u32x4 w;
            w.x = pk2(bflo(v.x) * g0.x * bflo(gb.x), bfhi(v.x) * g0.y * bfhi(gb.x));
            w.y = pk2(bflo(v.y) * g0.z * bflo(gb.y), bfhi(v.y) * g0.w * bfhi(gb.y));
            w.z = pk2(bflo(v.z) * g1.x * bflo(gb.z), bfhi(v.z) * g1.y * bfhi(gb.z));
            w.w = pk2(bflo(v.w) * g1.z * bflo(gb.w), bfhi(v.w) * g1.w * bfhi(gb.w));
            *(u32x4*)(Y + token * 2048 + 1024 + col) = w;
        }
    }
    __syncthreads();
}

DI void p4_final_rows(const float* x, const bf16_t* dl, float* out, const float* g, int gw, int nw, int lane) {
    for (int row = gw; row < MTOK; row += nw) {
        const f32x4* xr = (const f32x4*)(x + (size_t)row * DM) + lane;
        const u32x2* dr = (const u32x2*)(dl + (size_t)row * DM) + lane;
        f32x4 v[8]; float s = 0.f;
#pragma unroll
        for (int j = 0; j < 8; ++j) { const f32x4 xv = __builtin_nontemporal_load(xr + 64 * j); const u32x2 d2 = __builtin_nontemporal_load(dr + 64 * j);
            v[j].x = xv.x + bflo(d2.x); v[j].y = xv.y + bfhi(d2.x); v[j].z = xv.z + bflo(d2.y); v[j].w = xv.w + bfhi(d2.y);
            s += (v[j].x * v[j].x + v[j].y * v[j].y) + (v[j].z * v[j].z + v[j].w * v[j].w); }
        s = wave_sum(s);
        const float rstd = __builtin_amdgcn_rsqf(s * (1.0f / DM) + EPS);
        f32x4* ow = (f32x4*)(out + (size_t)row * DM) + lane;
#pragma unroll
        for (int j = 0; j < 8; ++j) { const f32x4 gg = ((const f32x4*)g)[lane + 64 * j]; __builtin_nontemporal_store(v[j] * rstd * gg, ow + 64 * j); }
    }
}

__global__ __launch_bounds__(NTHREADS, 2) void hymba_mega(Params p) {
    extern __shared__ __attribute__((aligned(16))) char lds[];
    cg::grid_group grid = cg::this_grid();
    const int tid = threadIdx.x, lane = tid & 63, wid = __builtin_amdgcn_readfirstlane(tid >> 6);
    const int bid = blockIdx.x, G = gridDim.x;
    const int gw = bid * 8 + wid, nw = G * 8;

    {
#if PROBE_REP == 1
    p0_rmsnorm_rows(p.in[0], p.in[1], (bf16_t*)(p.ws + WS_H), gw, nw, lane);
#endif
    p0_rmsnorm_rows(p.in[0], p.in[1], (bf16_t*)(p.ws + WS_H), gw, nw, lane);
    {
        float* scr = (float*)lds + wid * (64 * 33);
        const int n1 = (DM / 64) * (DIN / 32), n2 = (DM / 64) * (DM / 32);
        for (int it = gw; it < n1 + n2; it += nw) {
            if (it < n1) p0_transpose_item(p.in[2], DM, DIN, (bf16_t*)(p.ws + WS_WIN), scr, it, lane);
            else p0_transpose_item(p.in[13], DM, DM, (bf16_t*)(p.ws + WS_WOUT), scr, it - n1, lane);
        }
    }
    }
    grid.sync();

    {
#if PROBE_REP == 2
        gemm_phase<0>((lds_ptr)lds, (const bf16_t*)(p.ws + WS_H), (const bf16_t*)(p.ws + WS_WIN), DM, MTOK / BM, DIN / BM, bid, G, p, wid);
#endif
        gemm_phase<0>((lds_ptr)lds, (const bf16_t*)(p.ws + WS_H), (const bf16_t*)(p.ws + WS_WIN), DM, MTOK / BM, DIN / BM, bid, G, p, wid);
    }
    grid.sync();

    {
        int tid2 = fresh_tid(wid);
        const int tid = tid2, lane = tid & 63;
        for (int rep_ = 0; rep_ < (PROBE_REP == 3 ? 2 : 1); ++rep_)
        for (int item = bid; item < 256; item += G) sgu_item(p, item, lds, tid, lane, wid);
        const int tidA = fresh_tid(wid), laneA = tidA & 63;
        float lam;
        { const float a = wave_sum(p.in[7][laneA] * p.in[8][laneA]), c = wave_sum(p.in[9][laneA] * p.in[10][laneA]); lam = __uint_as_float(__builtin_amdgcn_readfirstlane(__float_as_uint(__expf(a) - __expf(c) + 0.2f))); }
        for (int rep_ = 0; rep_ < (PROBE_REP == 4 ? 2 : 1); ++rep_)
        for (int it = bid; it < 1024; it += G) {
            const int xcd = it & 7, rest = it >> 3;
            const int bh = xcd * 2 + (rest >> 6), j = rest & 63;
            attn_unit(p, bh, 127 - j, lds, lam, tidA, laneA, wid, true);
            attn_unit(p, bh, j, lds, lam, tidA, laneA, wid, false);
        }
    }
    grid.sync();

    {
#if PROBE_REP == 5
        gemm_phase<1>((lds_ptr)lds, (const bf16_t*)(p.ws + WS_Y), (const bf16_t*)(p.ws + WS_WOUT), DM, MTOK / BM, DM / BM, bid, G, p, wid);
#endif
        gemm_phase<1>((lds_ptr)lds, (const bf16_t*)(p.ws + WS_Y), (const bf16_t*)(p.ws + WS_WOUT), DM, MTOK / BM, DM / BM, bid, G, p, wid);
    }
    grid.sync();

    {
        const int t4 = fresh_tid(wid);
        p4_final_rows(p.in[0], (const bf16_t*)(p.ws + WS_H), p.out, p.in[14], bid * 8 + wid, nw, t4 & 63);
    }
}

extern "C" void kernel_launch(void* const* d_in, const int* in_sizes, int n_in, void* d_out, int out_size, void* d_ws, size_t ws_size, hipStream_t stream) {
    static int grid_blocks = 0;
    if (grid_blocks == 0) {
        if (n_in != 15 || ws_size < WS_END) { fprintf(stderr, "kernel_launch: unexpected n_in %d / ws_size %zu\n", n_in, ws_size); grid_blocks = -1; return; }
        int dev = 0, cus = 0, per_cu = 0;
        hipGetDevice(&dev);
        hipDeviceGetAttribute(&cus, hipDeviceAttributeMultiprocessorCount, dev);
        if (hipFuncSetAttribute((const void*)hymba_mega, hipFuncAttributeMaxDynamicSharedMemorySize, LDS_BYTES) != hipSuccess) fprintf(stderr, "kernel_launch: hipFuncSetAttribute failed\n");
        if (hipOccupancyMaxActiveBlocksPerMultiprocessor(&per_cu, (const void*)hymba_mega, NTHREADS, LDS_BYTES) != hipSuccess || per_cu < 1) { fprintf(stderr, "kernel_launch: occupancy query gave %d\n", per_cu); per_cu = 1; }
        (void)hipGetLastError();
        grid_blocks = cus * 1;
    }
    if (grid_blocks < 0) return;
    Params p{};
    for (int i = 0; i < 15; ++i) p.in[i] = (const float*)d_in[i];
    p.out = (float*)d_out; p.ws = (char*)d_ws;
    void* args[] = {&p};
    hipError_t e = hipLaunchCooperativeKernel((const void*)hymba_mega, dim3(grid_blocks), dim3(NTHREADS), args, LDS_BYTES, stream);
    if (e != hipSuccess) fprintf(stderr, "cooperative launch failed: %s (grid %d)\n", hipGetErrorString(e), grid_blocks);
}
```
